# Optimizing an MI355X kernel written in HIP

```python
import jax
import jax.numpy as jnp
from jax import lax
import numpy as np

D_MODEL = 4096
BATCH = 4
SEQ = 4096
DEPTH = 1

EPS = 1e-6
N_MEM = 256
D_MIX = D_MODEL
GLA_HEADS = 8
GLA_DV = D_MIX // 2
GLA_DK = GLA_DV // 2
GLA_HEAD_K = GLA_DK // GLA_HEADS
GLA_HEAD_V = GLA_DV // GLA_HEADS
GLA_GATE_RANK = 16
GLA_GATE_NORM = 16.0
GLA_CHUNK = 64
MOBA_WIDTH = D_MIX - GLA_DV
MOBA_HEAD_DIM = 128
MOBA_HEADS = MOBA_WIDTH // MOBA_HEAD_DIM
MOBA_BLOCK = 256
MOBA_TOPK = 3
MOBA_QCHUNK = 16
ROPE_THETA = 500000.0
ROPE_DIM = MOBA_HEAD_DIM // 4
CROSS_HEADS = 4
CROSS_HEAD_DIM = D_MODEL // CROSS_HEADS
D_FF = 4 * D_MODEL
IN_SIZES = (GLA_DK, GLA_DK, GLA_DV, GLA_GATE_RANK, GLA_DV, MOBA_WIDTH, MOBA_WIDTH, MOBA_WIDTH)
IN_WIDTH = 2 * GLA_DK + 2 * GLA_DV + GLA_GATE_RANK + 3 * MOBA_WIDTH

kernel_name = 'hybrid_gla_moba_block'


def rms_norm(x, g):
    xf = x.astype(jnp.float32)
    y = xf * lax.rsqrt(jnp.mean(xf * xf, axis=-1, keepdims=True) + EPS)
    return (y * g.astype(jnp.float32)).astype(x.dtype)


def partial_rotary(x, pos):
    half = ROPE_DIM // 2
    inv_freq = ROPE_THETA ** (-jnp.arange(0, ROPE_DIM, 2, dtype=jnp.float32) / ROPE_DIM)
    ang = pos.astype(jnp.float32)[:, None] * inv_freq[None, :]
    cos, sin = jnp.cos(ang), jnp.sin(ang)
    x1, x2, xp = x[..., :half], x[..., half:ROPE_DIM], x[..., ROPE_DIM:]
    rot = jnp.concatenate([x1 * cos - x2 * sin, x1 * sin + x2 * cos], axis=-1)
    return jnp.concatenate([rot.astype(x.dtype), xp], axis=-1)


def gla_chunked(q, k, v, g):
    B, H, S, dk = q.shape
    dv = v.shape[-1]
    C = GLA_CHUNK
    N = S // C
    f32 = jnp.float32
    out_dtype = v.dtype
    q = q.astype(f32) * (dk ** -0.5)
    k, v, g = k.astype(f32), v.astype(f32), g.astype(f32)
    q, k, g = (t.reshape(B, H, N, C, dk) for t in (q, k, g))
    v = v.reshape(B, H, N, C, dv)
    b = jnp.cumsum(g, axis=3)
    b_last = b[:, :, :, -1:, :]
    q_dec = q * jnp.exp(b)
    k_inv = k * jnp.exp(-b)
    k_end = k * jnp.exp(b_last - b)
    causal = jnp.tril(jnp.ones((C, C), dtype=bool))
    A = jnp.where(causal, jnp.einsum('bhnck,bhnsk->bhncs', q_dec, k_inv), 0.0)
    o_intra = jnp.einsum('bhncs,bhnsv->bhncv', A, v)
    dS = jnp.einsum('bhnsk,bhnsv->bhnkv', k_end, v)
    decay = jnp.exp(b_last[:, :, :, 0, :])

    def step(state, inp):
        d, ds = inp
        return state * d[..., None] + ds, state

    s0 = jnp.zeros((B, H, dk, dv), f32)
    _, s_before = lax.scan(step, s0, (jnp.moveaxis(decay, 2, 0), jnp.moveaxis(dS, 2, 0)))
    s_before = jnp.moveaxis(s_before, 0, 2)
    o_inter = jnp.einsum('bhnck,bhnkv->bhncv', q_dec, s_before)
    return (o_intra + o_inter).reshape(B, H, S, dv).astype(out_dtype)


def moba_attention(q, k, v):
    B, H, S, dh = q.shape
    L = MOBA_BLOCK
    NB = -(-S // L)
    pad = NB * L - S
    f32 = jnp.float32
    kp = jnp.pad(k, ((0, 0), (0, 0), (0, pad), (0, 0)))
    vp = jnp.pad(v, ((0, 0), (0, 0), (0, pad), (0, 0)))
    kb = kp.reshape(B, H, NB, L, dh)
    vb = vp.reshape(B, H, NB, L, dh)
    k_mean = jnp.mean(kb.astype(f32), axis=3)
    pos = jnp.arange(S)
    q_blk = pos // L
    gate = jnp.einsum('bhsd,bhnd->bhsn', q.astype(f32), k_mean)
    past = jnp.arange(NB)[None, :] < q_blk[:, None]
    gate = jnp.where(past, gate, -jnp.inf)
    topk = min(MOBA_TOPK, NB)
    _, sel = lax.top_k(gate, topk)
    sel_valid = sel < q_blk[:, None]

    QC = MOBA_QCHUNK
    NQ = S // QC
    qc = jnp.moveaxis(q.reshape(B, H, NQ, QC, dh), 2, 0)
    selc = jnp.moveaxis(sel.reshape(B, H, NQ, QC, topk), 2, 0)
    validc = jnp.moveaxis(sel_valid.reshape(B, H, NQ, QC, topk), 2, 0)
    starts = jnp.arange(NQ) * QC
    b_ix = jnp.arange(B)[:, None, None, None]
    h_ix = jnp.arange(H)[None, :, None, None]
    scale = dh ** -0.5

    def one_chunk(args):
        qq, ss, vv, start = args
        blk = start // L
        k_own = lax.dynamic_index_in_dim(kb, blk, axis=2, keepdims=False)
        v_own = lax.dynamic_index_in_dim(vb, blk, axis=2, keepdims=False)
        q_pos = start + jnp.arange(QC)
        k_pos = blk * L + jnp.arange(L)
        s_own = jnp.einsum('bhqd,bhkd->bhqk', qq, k_own).astype(f32) * scale
        s_own = jnp.where(k_pos[None, :] <= q_pos[:, None], s_own, -jnp.inf)
        k_sel = kb[b_ix, h_ix, ss]
        v_sel = vb[b_ix, h_ix, ss]
        s_sel = jnp.einsum('bhqd,bhqjkd->bhqjk', qq, k_sel).astype(f32) * scale
        s_sel = jnp.where(vv[..., None], s_sel, -jnp.inf).reshape(B, H, QC, topk * L)
        p = jax.nn.softmax(jnp.concatenate([s_own, s_sel], axis=-1), axis=-1)
        p_own = p[..., :L].astype(v.dtype)
        p_sel = p[..., L:].reshape(B, H, QC, topk, L).astype(v.dtype)
        return (jnp.einsum('bhqk,bhkd->bhqd', p_own, v_own)
                + jnp.einsum('bhqjk,bhqjkd->bhqd', p_sel, v_sel))

    o = lax.map(one_chunk, (qc, selc, validc, starts))
    return jnp.moveaxis(o, 0, 2).reshape(B, H, S, dh)


def hybrid_mixer(xn, w_in, w_gate_up, b_gate, gla_norm_g, w_out):
    B, S, _ = xn.shape
    proj = xn @ w_in
    gq, gk, gv, g_low, g_out, mq, mk, mv = jnp.split(
        proj, np.cumsum(IN_SIZES)[:-1].tolist(), axis=-1)

    def heads(t, n):
        return t.reshape(B, S, n, -1).transpose(0, 2, 1, 3)

    g_log = jax.nn.log_sigmoid((g_low @ w_gate_up + b_gate).astype(jnp.float32)) / GLA_GATE_NORM
    o_gla = gla_chunked(heads(gq, GLA_HEADS), heads(gk, GLA_HEADS),
                        heads(gv, GLA_HEADS), heads(g_log, GLA_HEADS))
    o_gla = rms_norm(o_gla.transpose(0, 2, 1, 3), gla_norm_g)
    o_gla = (o_gla * jax.nn.silu(g_out.reshape(B, S, GLA_HEADS, GLA_HEAD_V))).reshape(B, S, GLA_DV)

    pos = jnp.arange(S)
    q = partial_rotary(heads(mq, MOBA_HEADS), pos)
    k = partial_rotary(heads(mk, MOBA_HEADS), pos)
    o_moba = moba_attention(q, k, heads(mv, MOBA_HEADS))
    o_moba = o_moba.transpose(0, 2, 1, 3).reshape(B, S, MOBA_WIDTH)

    return jnp.concatenate([o_gla, o_moba], axis=-1) @ w_out


def cross_attention(hn, mem_n, w_cq, w_ck, w_cv, w_co):
    B, S, D = hn.shape
    M = mem_n.shape[1]
    q = (hn @ w_cq).reshape(B, S, CROSS_HEADS, CROSS_HEAD_DIM)
    k = (mem_n @ w_ck).reshape(B, M, CROSS_HEADS, CROSS_HEAD_DIM)
    v = (mem_n @ w_cv).reshape(B, M, CROSS_HEADS, CROSS_HEAD_DIM)
    s = jnp.einsum('bshd,bmhd->bhsm', q, k).astype(jnp.float32) * (CROSS_HEAD_DIM ** -0.5)
    p = jax.nn.softmax(s, axis=-1).astype(v.dtype)
    o = jnp.einsum('bhsm,bmhd->bshd', p, v).reshape(B, S, D)
    return o @ w_co


def squared_relu_mlp(hn, w_up, w_down):
    return jnp.square(jax.nn.relu(hn @ w_up)) @ w_down


def setup_inputs(seed: int = 0) -> dict:
    key = jax.random.key(seed)
    ks = jax.random.split(key, 20)
    f32 = jnp.float32

    def w(k, shape, fan_in):
        return jax.random.normal(k, shape, f32) * (fan_in ** -0.5)

    def gain(k, shape):
        return 1.0 + 0.02 * jax.random.normal(k, shape, f32)

    L = DEPTH
    return {
        'x': jax.random.normal(ks[0], (BATCH, SEQ, D_MODEL), f32),
        'mem': jax.random.normal(ks[1], (BATCH, N_MEM, D_MODEL), f32),
        'norm_mix_g': gain(ks[2], (L, D_MODEL)),
        'w_in': w(ks[3], (L, D_MODEL, IN_WIDTH), D_MODEL),
        'w_gate_up': w(ks[4], (L, GLA_GATE_RANK, GLA_DK), GLA_GATE_RANK),
        'b_gate': 0.1 * jax.random.normal(ks[5], (L, GLA_DK), f32),
        'gla_norm_g': gain(ks[6], (L, GLA_HEAD_V)),
        'w_out': w(ks[7], (L, D_MIX, D_MODEL), D_MIX),
        'norm_cross_g': gain(ks[8], (L, D_MODEL)),
        'norm_mem_g': gain(ks[9], (L, D_MODEL)),
        'w_cq': w(ks[10], (L, D_MODEL, D_MODEL), D_MODEL),
        'w_ck': w(ks[11], (L, D_MODEL, D_MODEL), D_MODEL),
        'w_cv': w(ks[12], (L, D_MODEL, D_MODEL), D_MODEL),
        'w_co': w(ks[13], (L, D_MODEL, D_MODEL), D_MODEL),
        'norm_mlp_g': gain(ks[14], (L, D_MODEL)),
        'w_up': w(ks[15], (L, D_MODEL, D_FF), D_MODEL),
        'w_down': w(ks[16], (L, D_FF, D_MODEL), D_FF),
        'norm_final_g': gain(ks[17], (D_MODEL,)),
    }


def reference(x, mem, norm_mix_g, w_in, w_gate_up, b_gate, gla_norm_g, w_out,
              norm_cross_g, norm_mem_g, w_cq, w_ck, w_cv, w_co,
              norm_mlp_g, w_up, w_down, norm_final_g):
    h = x
    for l in range(DEPTH):
        h = h + hybrid_mixer(rms_norm(h, norm_mix_g[l]), w_in[l], w_gate_up[l],
                             b_gate[l], gla_norm_g[l], w_out[l])
        h = h + cross_attention(rms_norm(h, norm_cross_g[l]), rms_norm(mem, norm_mem_g[l]),
                                w_cq[l], w_ck[l], w_cv[l], w_co[l])
        h = h + squared_relu_mlp(rms_norm(h, norm_mlp_g[l]), w_up[l], w_down[l])
    return rms_norm(h, norm_final_g)
```

```cpp
#include <hip/hip_runtime.h>
#include <cstdio>
#include <cstdint>

#ifndef PROBE_DUP
#define PROBE_DUP 0
#define PROBE_DUP_N 1
#endif
#ifndef MK_ONE_LAUNCH
#define MK_ONE_LAUNCH 1
#endif

constexpr int BATCH = 4, SEQ = 4096, DM = 4096, T = BATCH * SEQ;
constexpr int NMEM = 256, TM = BATCH * NMEM;
constexpr int INW = 12304, IN_N = 12288, PROJ_LD = 6144;
constexpr int C_GQ = 0, C_GK = 1024, C_GV = 2048, C_GOUT = 4096;
constexpr size_t QKVH_T = (size_t)BATCH * 16 * SEQ * 128;
constexpr int DFF = 16384, U_LD = DFF + 64;
constexpr float EPS = 1e-6f;
constexpr int RQ_LD = DFF + 128;
constexpr int IN_Q0 = 6144;

constexpr size_t MiB = 1u << 20;
constexpr size_t WS_CTL = 0, CTL_ZERO_BYTES = 32768;
constexpr size_t WS_RSTDX = 1 * MiB, WS_RSTD1 = WS_RSTDX + 65536, WS_RSTD2 = WS_RSTD1 + 65536;
constexpr size_t WS_ROPEC = 1 * MiB + 262144, WS_ROPES = WS_ROPEC + 262144, WS_KMEAN = WS_ROPES + 262144;
constexpr size_t WS_GLOW = 3 * MiB, WS_PART = 4 * MiB;
constexpr size_t WS_WIN = 8 * MiB, WS_WOUT = 104 * MiB, WS_WCKV = 136 * MiB, WS_WCQ = 200 * MiB, WS_WCO = 232 * MiB, WS_WUP = 264 * MiB, WS_WDN = 392 * MiB;
constexpr size_t WS_WQK = 520 * MiB, WS_WVO = 552 * MiB, WS_KCVC = 584 * MiB, WS_MEMN = 600 * MiB, WS_HB = 608 * MiB, WS_BIG = 736 * MiB, WS_DECAY = 1252 * MiB, WS_WGLOW = 1253 * MiB, WS_END = 1254 * MiB;
constexpr size_t WS_UQ = 8 * MiB, WS_WDQ = 268 * MiB;
constexpr size_t WS_PROJ = WS_BIG, WS_QKVH = WS_BIG + 192 * MiB, WS_OMIX = WS_BIG + 384 * MiB, WS_P = WS_BIG, WS_U = WS_BIG;

#define GAS __attribute__((address_space(1)))
#define LAS __attribute__((address_space(3)))
typedef unsigned short bf16_t;
typedef short bf16x8 __attribute__((ext_vector_type(8)));
typedef short s16x4 __attribute__((ext_vector_type(4)));
typedef float f32x2 __attribute__((ext_vector_type(2)));
typedef float f32x4 __attribute__((ext_vector_type(4)));
typedef float f32x16 __attribute__((ext_vector_type(16)));
typedef unsigned u32x2 __attribute__((ext_vector_type(2)));
typedef unsigned u32x4 __attribute__((ext_vector_type(4)));
typedef int i32x4 __attribute__((ext_vector_type(4)));

typedef _Float16 h16x2 __attribute__((ext_vector_type(2)));
typedef _Float16 h16x8 __attribute__((ext_vector_type(8)));
__device__ __forceinline__ unsigned cvt_pk_bf16(float lo, float hi) { unsigned r; asm volatile("v_cvt_pk_f16_f32 %0, %1, %2" : "=v"(r) : "v"(lo), "v"(hi)); return r; }
__device__ __forceinline__ float bf2f(unsigned short b) { return (float)__builtin_bit_cast(_Float16, b); }
__device__ __forceinline__ float bflo(unsigned w) { return (float)__builtin_bit_cast(h16x2, w)[0]; }
__device__ __forceinline__ float bfhi(unsigned w) { return (float)__builtin_bit_cast(h16x2, w)[1]; }
__device__ __forceinline__ f32x4 mfma16_h(bf16x8 a, bf16x8 b, f32x4 c) { return __builtin_amdgcn_mfma_f32_16x16x32_f16(__builtin_bit_cast(h16x8, a), __builtin_bit_cast(h16x8, b), c, 0, 0, 0); }
__device__ __forceinline__ f32x16 mfma32_h(bf16x8 a, bf16x8 b, f32x16 c) { return __builtin_amdgcn_mfma_f32_32x32x16_f16(__builtin_bit_cast(h16x8, a), __builtin_bit_cast(h16x8, b), c, 0, 0, 0); }

namespace pg8 {
constexpr int BM = 256, BK = 64, HALF = 128, HTB = HALF * BK * 2, STAGE_BYTES = 8 * HTB, NXCD = 8, WGM = 8;
__host__ __device__ __forceinline__ int lds_byte(int r, int c) { const int st = (r >> 4) * 2 + (c >> 5), rr = r & 15, cc = c & 31, ob = rr * 64 + cc * 2; return st * 1024 + (ob ^ (((ob >> 9) & 1) << 5)); }
__host__ __device__ __forceinline__ void stage_rc(int b, int& R, int& C) { const int st = b / 1024, sb = b % 1024, swz = sb ^ (((sb >> 9) & 1) << 5); R = (st >> 1) * 16 + swz / 64; C = (st & 1) * 32 + (swz % 64) / 2; }
__host__ __device__ __forceinline__ int perm32(int rho) { const int n = rho >> 4, i = rho & 15; return 8 * (i >> 2) + 4 * n + (i & 3); }
struct Unit { int pm, pn; };

struct StaticOrder {
    int nM, nN, nwg, G, c;
    __device__ void init(int M, int N, int G_, int c_) { nM = M / BM; nN = N / BM; nwg = nM * nN; G = G_; c = c_; }
    __device__ __forceinline__ bool next(int i, Unit& u) const {
        const long L = (long)i * G + c; if (L >= nwg) return false;
        int wgid = (int)L; { const int q = nwg / NXCD, r = nwg % NXCD, xcd = wgid % NXCD, off = wgid / NXCD; wgid = (xcd < r ? xcd * (q + 1) : r * (q + 1) + (xcd - r) * q) + off; }
        const int nig = WGM * nN, gid = wgid / nig, fm = gid * WGM, gsz = (nM - fm) < WGM ? (nM - fm) : WGM;
        u.pm = fm + ((wgid % nig) % gsz); u.pn = (wgid % nig) / gsz; return true;
    }
};
struct LinearOrder {
    int n, G, c, base;
    __device__ __forceinline__ bool next(int i, Unit& u) const { const int L = i * G + c; if (L >= n) return false; u.pm = base + L; u.pn = 0; return true; }
};
struct StdPtrs {
    const char* A; const char* Bt; int K, lda, ldb, pmb; size_t bstride;
    __device__ __forceinline__ const char* a(const Unit& u) const { return A + (size_t)u.pm * BM * lda * 2; }
    __device__ __forceinline__ const char* b(const Unit& u) const { return Bt + (size_t)u.pn * BM * ldb * 2 + (pmb ? (size_t)(u.pm / pmb) * bstride : 0); }
};

template <bool I8> struct AccT { typedef f32x4 type; };
template <> struct AccT<true> { typedef i32x4 type; };
template <class Epi, class Sched, class Ptrs, bool ALIGN_EPI, bool I8 = false>
__device__ __forceinline__ void gemm_phase(LAS unsigned char* lds, const Ptrs& P, const Sched& S, const Epi& E) {
    const int tid = threadIdx.x, wid = __builtin_amdgcn_readfirstlane(tid >> 6), lane = tid & 63, wr = wid >> 2, wc = wid & 3, fr = lane & 15, fq = lane >> 4;
    const int K = P.K, nt = K / BK;
    unsigned voffA[2], voffB[2];
#pragma unroll
    for (int i = 0; i < 2; ++i) { int R, C; stage_rc(tid * 16 + i * 8192, R, C); const int Rb = Epi::PERM ? ((R & ~31) + perm32(R & 31)) : R;
        voffA[i] = (unsigned)(R * P.lda + C) * 2u; voffB[i] = (unsigned)(Rb * P.ldb + C) * 2u; }
    const size_t kstep = (size_t)(BK * 2);
    const size_t hstepA = (size_t)HALF * P.lda * 2, hstepB = (size_t)HALF * P.ldb * 2;
    const unsigned ldsw = (unsigned)wid * 1024u;
    const int aoff = lds_byte(wr * 64 + fr, fq * 8), boff = lds_byte(wc * 32 + fr, fq * 8);
#define PG8_SA(b, h) (((b) * 2 + (h)) * HTB)
#define PG8_SB(b, h) ((4 + (b) * 2 + (h)) * HTB)
#define PG8_STAGE(bufoff, gbase, voff) do { _Pragma("unroll") for (int _i = 0; _i < 2; ++_i) \
        __builtin_amdgcn_global_load_lds((const unsigned*)((const char*)(gbase) + (voff)[_i]), (LAS unsigned*)(lds + (bufoff) + ldsw + _i * 8192), 16, 0, 0); } while (0)
#define PG8_LDA(dst, b, h) do { _Pragma("unroll") for (int m = 0; m < 4; ++m) _Pragma("unroll") for (int k = 0; k < 2; ++k) dst[m][k] = *(const LAS bf16x8*)(lds + PG8_SA(b, h) + aoff + m * 2048 + k * 1024); } while (0)
#define PG8_LDB(dst, b, h) do { _Pragma("unroll") for (int n = 0; n < 2; ++n) _Pragma("unroll") for (int k = 0; k < 2; ++k) dst[n][k] = *(const LAS bf16x8*)(lds + PG8_SB(b, h) + boff + n * 2048 + k * 1024); } while (0)
#define PG8_MMA(ai, bj, At, Bt) do { __builtin_amdgcn_s_setprio(1); _Pragma("unroll") for (int m = 0; m < 4; ++m) _Pragma("unroll") for (int n = 0; n < 2; ++n) _Pragma("unroll") for (int k = 0; k < 2; ++k) { \
        if constexpr (I8) acc[ai][bj][m][n] = __builtin_amdgcn_mfma_i32_16x16x64_i8(__builtin_bit_cast(i32x4, Bt[n][k]), __builtin_bit_cast(i32x4, At[m][k]), acc[ai][bj][m][n], 0, 0, 0); \
        else acc[ai][bj][m][n] = mfma16_h(Bt[n][k], At[m][k], acc[ai][bj][m][n]); } __builtin_amdgcn_s_setprio(0); } while (0)
#define PG8_WAIT_V(n) asm volatile("s_waitcnt vmcnt(" #n ")" ::: "memory")
#define PG8_WAIT_L(n) asm volatile("s_waitcnt lgkmcnt(" #n ")" ::: "memory")
#define PG8_BAR __builtin_amdgcn_s_barrier()
#define PG8_SCHED __builtin_amdgcn_sched_barrier(0)
    Unit cur, nxt; int ui = 0;
    if (!S.next(0, cur)) return;
    typedef typename AccT<I8>::type acc_t;
    acc_t acc[2][2][4][2];
#pragma unroll
    for (int a = 0; a < 2; ++a)
#pragma unroll
        for (int b = 0; b < 2; ++b)
#pragma unroll
            for (int m = 0; m < 4; ++m)
#pragma unroll
                for (int n = 0; n < 2; ++n) acc[a][b][m][n] = acc_t{};
    bf16x8 At[4][2], B0[2][2], B1[2][2];
    const char* cA = P.a(cur); const char* cB = P.b(cur);
    PG8_STAGE(PG8_SB(0, 0), cB, voffB); PG8_STAGE(PG8_SB(0, 1), cB + hstepB, voffB); PG8_STAGE(PG8_SA(0, 0), cA, voffA); PG8_STAGE(PG8_SA(0, 1), cA + hstepA, voffA);
    if (wr == 1) PG8_BAR;
    PG8_WAIT_V(2); PG8_BAR;
    PG8_STAGE(PG8_SB(1, 0), cB + kstep, voffB); PG8_STAGE(PG8_SA(1, 0), cA + kstep, voffA); PG8_STAGE(PG8_SB(1, 1), cB + hstepB + kstep, voffB);
    PG8_WAIT_V(6); PG8_BAR;
    for (;;) {
        const bool has_next = S.next(ui + 1, nxt);
        const char* nA = has_next ? P.a(nxt) : cA; const char* nB = has_next ? P.b(nxt) : cB;
        for (int t = 0; t < nt; t += 2) {
            const bool last = (t == nt - 2);
            const char* a1 = cA + (size_t)(t + 1) * kstep;
            const char* a2 = last ? nA : cA + (size_t)(t + 2) * kstep; const char* b2 = last ? nB : cB + (size_t)(t + 2) * kstep;
            const char* a3 = a2 + kstep; const char* b3 = b2 + kstep;
            PG8_LDB(B0, 0, 0); PG8_LDB(B1, 0, 1); PG8_SCHED; PG8_LDA(At, 0, 0); PG8_STAGE(PG8_SA(1, 1), a1 + hstepA, voffA);
            PG8_WAIT_V(8); PG8_WAIT_L(0); PG8_BAR; PG8_MMA(0, 0, At, B0); PG8_MMA(0, 1, At, B1); PG8_BAR; PG8_SCHED;
            PG8_LDA(At, 0, 1); PG8_STAGE(PG8_SB(0, 0), b2, voffB); PG8_STAGE(PG8_SB(0, 1), b2 + hstepB, voffB); PG8_STAGE(PG8_SA(0, 0), a2, voffA);
            PG8_WAIT_V(8); PG8_WAIT_L(0); PG8_BAR; PG8_MMA(1, 0, At, B0); PG8_MMA(1, 1, At, B1); PG8_BAR; PG8_SCHED;
            PG8_LDB(B0, 1, 0); PG8_LDB(B1, 1, 1); PG8_SCHED; PG8_LDA(At, 1, 0); PG8_STAGE(PG8_SA(0, 1), a2 + hstepA, voffA);
            PG8_WAIT_V(8); PG8_WAIT_L(0); PG8_BAR; PG8_MMA(0, 0, At, B0); PG8_MMA(0, 1, At, B1); PG8_BAR; PG8_SCHED;
            PG8_LDA(At, 1, 1); PG8_STAGE(PG8_SB(1, 0), b3, voffB); PG8_STAGE(PG8_SB(1, 1), b3 + hstepB, voffB); PG8_STAGE(PG8_SA(1, 0), a3, voffA);
            PG8_WAIT_V(8); PG8_WAIT_L(0); PG8_BAR; PG8_MMA(1, 0, At, B0); PG8_MMA(1, 1, At, B1); PG8_BAR; PG8_SCHED;
        }
        if constexpr (ALIGN_EPI) { if (wr == 0) PG8_BAR; }
        if constexpr (!Epi::AFTER_DRAIN) { E(acc, cur, wr, wc, fr, fq); }
        if (!has_next) break;
#pragma unroll
        for (int a = 0; a < 2; ++a)
#pragma unroll
            for (int b = 0; b < 2; ++b)
#pragma unroll
                for (int m = 0; m < 4; ++m)
#pragma unroll
                    for (int n = 0; n < 2; ++n) acc[a][b][m][n] = acc_t{};
        cur = nxt; cA = nA; cB = nB; ++ui;
        if constexpr (ALIGN_EPI) { if (wr == 1) PG8_BAR; }
    }
    PG8_WAIT_V(0);
    if constexpr (!ALIGN_EPI) { if (wr == 0) PG8_BAR; }
    PG8_BAR;
    if constexpr (Epi::AFTER_DRAIN) { E.fused(acc, cur, wr, wc, fr, fq, lds, wid, lane); }
#undef PG8_SA
#undef PG8_SB
#undef PG8_STAGE
#undef PG8_LDA
#undef PG8_LDB
#undef PG8_MMA
#undef PG8_WAIT_V
#undef PG8_WAIT_L
#undef PG8_BAR
#undef PG8_SCHED
}

template <int ACT, bool RS_LDS = false> struct EpiBf16 {
    static constexpr bool PERM = true, AFTER_DRAIN = false;
    bf16_t* O; int ldc; const float* rstd;
    __device__ __forceinline__ void operator()(const f32x4 (&acc)[2][2][4][2], const Unit& u, int wr, int wc, int fr, int fq) const {
        const int row0 = u.pm * BM + wr * 64 + fr, col0 = u.pn * BM + wc * 32 + 8 * fq;
        float rsv[2][4];
#pragma unroll
        for (int ai = 0; ai < 2; ++ai)
#pragma unroll
            for (int m = 0; m < 4; ++m) rsv[ai][m] = RS_LDS ? ((const LAS float*)131072)[wr * 64 + fr + ai * HALF + m * 16] : (rstd ? rstd[row0 + ai * HALF + m * 16] : 1.f);
#pragma unroll
        for (int ai = 0; ai < 2; ++ai)
#pragma unroll
            for (int m = 0; m < 4; ++m) { const int row = row0 + ai * HALF + m * 16; const float rs = rsv[ai][m]; bf16_t* rowp = O + (size_t)row * ldc + col0;
#pragma unroll
                for (int bj = 0; bj < 2; ++bj) { f32x4 v0 = acc[ai][bj][m][0] * rs, v1 = acc[ai][bj][m][1] * rs;
                    if (ACT == 1) {
#pragma unroll
                        for (int j = 0; j < 4; ++j) { const float a = fmaxf(v0[j], 0.f), b = fmaxf(v1[j], 0.f); v0[j] = a * a; v1[j] = b * b; } }
                    u32x4 w; w.x = cvt_pk_bf16(v0[0], v0[1]); w.y = cvt_pk_bf16(v0[2], v0[3]); w.z = cvt_pk_bf16(v1[0], v1[1]); w.w = cvt_pk_bf16(v1[2], v1[3]);
                    *(u32x4*)(rowp + bj * HALF) = w; } }
    }
};
struct EpiProjMoba {
    static constexpr bool PERM = true, AFTER_DRAIN = false;
    bf16_t* O; bf16_t* QH; const float* rowq; const float* cscale; const float* ropec; const float* ropes; int pn0;
    __device__ __forceinline__ void operator()(const i32x4 (&acc)[2][2][4][2], const Unit& u, int wr, int wc, int fr, int fq) const {
        const int row0 = u.pm * BM + wr * 64 + fr, col0 = u.pn * BM + wc * 32 + 8 * fq, pa = u.pn + pn0;
        f32x4 cs[2][2];
#pragma unroll
        for (int bj = 0; bj < 2; ++bj) { cs[bj][0] = *(const f32x4*)(cscale + col0 + bj * HALF); cs[bj][1] = *(const f32x4*)(cscale + col0 + bj * HALF + 4); }
        const bool hm = pa >= 24, rope = hm && (pa < 40) && (wc == 0);
        const int t3 = (pa - 24) >> 3, hp = (pa - 24) & 7;
        float rsv[2][4];
#pragma unroll
        for (int ai = 0; ai < 2; ++ai)
#pragma unroll
            for (int m = 0; m < 4; ++m) rsv[ai][m] = rowq[row0 + ai * HALF + m * 16];
        f32x4 nc0 = {1.f, 1.f, 1.f, 1.f}, nc1 = nc0, ns0 = {0.f, 0.f, 0.f, 0.f}, ns1 = ns0;
        if (rope) { const int pos = row0 & (SEQ - 1); const float* cp = ropec + pos * 16 + 8 * (fq & 1); const float* sp = ropes + pos * 16 + 8 * (fq & 1);
            nc0 = *(const f32x4*)cp; nc1 = *(const f32x4*)(cp + 4); ns0 = *(const f32x4*)sp; ns1 = *(const f32x4*)(sp + 4); }
#pragma unroll
        for (int ai = 0; ai < 2; ++ai)
#pragma unroll
            for (int m = 0; m < 4; ++m) { const int row = row0 + ai * HALF + m * 16; const float rs = rsv[ai][m];
                bf16_t* rowp = hm ? QH + (size_t)t3 * QKVH_T + ((size_t)((row >> 12) * 16 + 2 * hp) * SEQ + (row & (SEQ - 1))) * 128 + wc * 32 + 8 * fq : O + (size_t)row * PROJ_LD + pa * BM + wc * 32 + 8 * fq;
                const size_t bjstep = hm ? (size_t)SEQ * 128 : (size_t)HALF;
                f32x4 c0 = nc0, c1 = nc1, s0 = ns0, s1 = ns1;
                if (rope) {
                    if (ai * 4 + m < 7) { const int g1 = ai * 4 + m + 1, pos = (row0 + (g1 >> 2) * HALF + (g1 & 3) * 16) & (SEQ - 1); const float* cp = ropec + pos * 16 + 8 * (fq & 1); const float* sp = ropes + pos * 16 + 8 * (fq & 1);
                        nc0 = *(const f32x4*)cp; nc1 = *(const f32x4*)(cp + 4); ns0 = *(const f32x4*)sp; ns1 = *(const f32x4*)(sp + 4); }
                    if (fq < 2) { s0 = -s0; s1 = -s1; } }
#pragma unroll
                for (int bj = 0; bj < 2; ++bj) { const i32x4 a0 = acc[ai][bj][m][0], a1 = acc[ai][bj][m][1];
                    f32x4 v0 = (f32x4){(float)a0[0], (float)a0[1], (float)a0[2], (float)a0[3]} * cs[bj][0] * rs, v1 = (f32x4){(float)a1[0], (float)a1[1], (float)a1[2], (float)a1[3]} * cs[bj][1] * rs;
                    if (rope) { f32x4 p0, p1;
#pragma unroll
                        for (int j = 0; j < 4; ++j) { p0[j] = __shfl_xor(v0[j], 32); p1[j] = __shfl_xor(v1[j], 32); }
                        v0 = v0 * c0 + p0 * s0; v1 = v1 * c1 + p1 * s1; }
                    u32x4 w; w.x = cvt_pk_bf16(v0[0], v0[1]); w.y = cvt_pk_bf16(v0[2], v0[3]); w.z = cvt_pk_bf16(v1[0], v1[1]); w.w = cvt_pk_bf16(v1[2], v1[3]);
                    *(u32x4*)(rowp + bj * bjstep) = w; } }
    }
};
struct EpiUpI8 {
    static constexpr bool PERM = true, AFTER_DRAIN = false;
    bf16_t* O; int ldc; const float* rowq; const float* cscale;
    __device__ __forceinline__ void operator()(const i32x4 (&acc)[2][2][4][2], const Unit& u, int wr, int wc, int fr, int fq) const {
        const int row0 = u.pm * BM + wr * 64 + fr, col0 = u.pn * BM + wc * 32 + 8 * fq;
        f32x4 cs[2][2];
#pragma unroll
        for (int bj = 0; bj < 2; ++bj) { cs[bj][0] = *(const f32x4*)(cscale + col0 + bj * HALF); cs[bj][1] = *(const f32x4*)(cscale + col0 + bj * HALF + 4); }
        float rsv[2][4];
#pragma unroll
        for (int ai = 0; ai < 2; ++ai)
#pragma unroll
            for (int m = 0; m < 4; ++m) rsv[ai][m] = rowq[row0 + ai * HALF + m * 16];
#pragma unroll
        for (int ai = 0; ai < 2; ++ai)
#pragma unroll
            for (int m = 0; m < 4; ++m) { const int row = row0 + ai * HALF + m * 16; const float rs = rsv[ai][m]; bf16_t* rowp = O + (size_t)row * ldc + col0;
#pragma unroll
                for (int bj = 0; bj < 2; ++bj) { const i32x4 a0 = acc[ai][bj][m][0], a1 = acc[ai][bj][m][1];
                    f32x4 v0 = (f32x4){(float)a0[0], (float)a0[1], (float)a0[2], (float)a0[3]} * cs[bj][0] * rs, v1 = (f32x4){(float)a1[0], (float)a1[1], (float)a1[2], (float)a1[3]} * cs[bj][1] * rs;
#pragma unroll
                    for (int j = 0; j < 4; ++j) { const float a = fmaxf(v0[j], 0.f), b = fmaxf(v1[j], 0.f); v0[j] = a * a; v1[j] = b * b; }
                    u32x4 w; w.x = cvt_pk_bf16(v0[0], v0[1]); w.y = cvt_pk_bf16(v0[2], v0[3]); w.z = cvt_pk_bf16(v1[0], v1[1]); w.w = cvt_pk_bf16(v1[2], v1[3]);
                    *(u32x4*)(rowp + bj * HALF) = w; } }
    }
};
template <bool BASE_F32> struct EpiResid {
    static constexpr bool PERM = true, AFTER_DRAIN = false;
    static_assert(!BASE_F32, "the residual base is bf16 in every phase of this kernel");
    const void* base; bf16_t* hout; float* part;
    __device__ __forceinline__ void operator()(const f32x4 (&acc)[2][2][4][2], const Unit& u, int wr, int wc, int fr, int fq) const {
        const int row0 = u.pm * BM + wr * 64 + fr, col0 = u.pn * BM + wc * 32 + 8 * fq;
#pragma unroll
        for (int ai = 0; ai < 2; ++ai) {
            u32x4 bw[4][2];
#pragma unroll
            for (int m = 0; m < 4; ++m)
#pragma unroll
                for (int bj = 0; bj < 2; ++bj) bw[m][bj] = *(const u32x4*)((const bf16_t*)base + (size_t)(row0 + ai * HALF + m * 16) * DM + col0 + bj * HALF);
#pragma unroll
            for (int m = 0; m < 4; ++m) { const int row = row0 + ai * HALF + m * 16; const size_t off = (size_t)row * DM + col0; float ss = 0.f;
#pragma unroll
                for (int bj = 0; bj < 2; ++bj) { const u32x4 w = bw[m][bj];
                    const f32x4 b0 = {bflo(w.x), bfhi(w.x), bflo(w.y), bfhi(w.y)}, b1 = {bflo(w.z), bfhi(w.z), bflo(w.w), bfhi(w.w)};
                    const f32x4 o0 = b0 + acc[ai][bj][m][0], o1 = b1 + acc[ai][bj][m][1];
                    ss += ((o0[0] * o0[0] + o0[1] * o0[1]) + (o0[2] * o0[2] + o0[3] * o0[3])) + ((o1[0] * o1[0] + o1[1] * o1[1]) + (o1[2] * o1[2] + o1[3] * o1[3]));
                    u32x4 w2; w2.x = cvt_pk_bf16(o0[0], o0[1]); w2.y = cvt_pk_bf16(o0[2], o0[3]); w2.z = cvt_pk_bf16(o1[0], o1[1]); w2.w = cvt_pk_bf16(o1[2], o1[3]);
                    *(u32x4*)(hout + off + bj * HALF) = w2; }
                ss += __shfl_xor(ss, 16); ss += __shfl_xor(ss, 32);
                if (fq == 0) part[(size_t)row * 64 + u.pn * 4 + wc] = ss; }
            asm volatile("" ::: "memory"); }
    }
};
struct EpiResidI8 {
    static constexpr bool PERM = true, AFTER_DRAIN = false;
    const bf16_t* base; bf16_t* hout; float* part; const float* sa; const float* mrow; const float* sw; const float* cw;
    __device__ __forceinline__ void operator()(const i32x4 (&acc)[2][2][4][2], const Unit& u, int wr, int wc, int fr, int fq) const {
        const int row0 = u.pm * BM + wr * 64 + fr, col0 = u.pn * BM + wc * 32 + 8 * fq;
        f32x4 cs[2][2], cc[2][2];
#pragma unroll
        for (int bj = 0; bj < 2; ++bj) { cs[bj][0] = *(const f32x4*)(sw + col0 + bj * HALF); cs[bj][1] = *(const f32x4*)(sw + col0 + bj * HALF + 4); cc[bj][0] = *(const f32x4*)(cw + col0 + bj * HALF); cc[bj][1] = *(const f32x4*)(cw + col0 + bj * HALF + 4); }
#pragma unroll
        for (int ai = 0; ai < 2; ++ai) {
            u32x4 bw[4][2]; float rs[4], rm[4];
#pragma unroll
            for (int m = 0; m < 4; ++m) { rs[m] = sa[row0 + ai * HALF + m * 16]; rm[m] = mrow[row0 + ai * HALF + m * 16];
#pragma unroll
                for (int bj = 0; bj < 2; ++bj) bw[m][bj] = *(const u32x4*)(base + (size_t)(row0 + ai * HALF + m * 16) * DM + col0 + bj * HALF); }
#pragma unroll
            for (int m = 0; m < 4; ++m) { const int row = row0 + ai * HALF + m * 16; const size_t off = (size_t)row * DM + col0; float ss = 0.f;
#pragma unroll
                for (int bj = 0; bj < 2; ++bj) { const u32x4 w = bw[m][bj]; const i32x4 a0 = acc[ai][bj][m][0], a1 = acc[ai][bj][m][1];
                    const f32x4 b0 = {bflo(w.x), bfhi(w.x), bflo(w.y), bfhi(w.y)}, b1 = {bflo(w.z), bfhi(w.z), bflo(w.w), bfhi(w.w)};
                    const f32x4 o0 = b0 + (f32x4){(float)a0[0], (float)a0[1], (float)a0[2], (float)a0[3]} * cs[bj][0] * rs[m] + cc[bj][0] * rm[m];
                    const f32x4 o1 = b1 + (f32x4){(float)a1[0], (float)a1[1], (float)a1[2], (float)a1[3]} * cs[bj][1] * rs[m] + cc[bj][1] * rm[m];
                    ss += ((o0[0] * o0[0] + o0[1] * o0[1]) + (o0[2] * o0[2] + o0[3] * o0[3])) + ((o1[0] * o1[0] + o1[1] * o1[1]) + (o1[2] * o1[2] + o1[3] * o1[3]));
                    u32x4 w2; w2.x = cvt_pk_bf16(o0[0], o0[1]); w2.y = cvt_pk_bf16(o0[2], o0[3]); w2.z = cvt_pk_bf16(o1[0], o1[1]); w2.w = cvt_pk_bf16(o1[2], o1[3]);
                    *(u32x4*)(hout + off + bj * HALF) = w2; }
                ss += __shfl_xor(ss, 16); ss += __shfl_xor(ss, 32);
                if (fq == 0) part[(size_t)row * 64 + u.pn * 4 + wc] = ss; }
            asm volatile("" ::: "memory"); }
    }
};
struct EpiSoftmax {
    static constexpr bool PERM = true, AFTER_DRAIN = true;
    bf16_t* Pm; const float* part;
    __device__ __forceinline__ void fused(f32x4 (&acc)[2][2][4][2], const Unit& u, int wr, int wc, int fr, int fq, LAS unsigned char* lds, int wid, int lane) const {
        LAS float* MX = (LAS float*)lds; LAS float* SM = (LAS float*)(lds + 4096); LAS float* RS = (LAS float*)(lds + 8192);
        const float C = 0.03125f * 1.4426950408889634f;
        { const int tid = wid * 64 + lane, rl = tid >> 1, hf = tid & 1; const f32x4* pp = (const f32x4*)(part + (size_t)(u.pm * BM + rl) * 64 + hf * 32); float s = 0.f;
#pragma unroll
          for (int j = 0; j < 8; ++j) { const f32x4 v = pp[j]; s += (v[0] + v[1]) + (v[2] + v[3]); }
          s += __shfl_xor(s, 1);
          if (hf == 0) RS[rl] = 1.0f / sqrtf(s * (1.0f / DM) + EPS); }
        asm volatile("s_waitcnt lgkmcnt(0)" ::: "memory"); __builtin_amdgcn_s_barrier(); asm volatile("" ::: "memory");
#pragma unroll
        for (int ai = 0; ai < 2; ++ai)
#pragma unroll
            for (int m = 0; m < 4; ++m) { const int r = ai * HALF + wr * 64 + m * 16 + fr; const float sc = RS[r] * C; float mx = -3.0e38f;
#pragma unroll
                for (int bj = 0; bj < 2; ++bj)
#pragma unroll
                    for (int n = 0; n < 2; ++n) { f32x4 v = acc[ai][bj][m][n] * sc; acc[ai][bj][m][n] = v; mx = fmaxf(fmaxf(mx, fmaxf(v[0], v[1])), fmaxf(v[2], v[3])); }
                mx = fmaxf(mx, __shfl_xor(mx, 16)); mx = fmaxf(mx, __shfl_xor(mx, 32));
                if (fq == 0) MX[r * 4 + wc] = mx; }
        asm volatile("s_waitcnt lgkmcnt(0)" ::: "memory"); __builtin_amdgcn_s_barrier(); asm volatile("" ::: "memory");
#pragma unroll
        for (int ai = 0; ai < 2; ++ai)
#pragma unroll
            for (int m = 0; m < 4; ++m) { const int r = ai * HALF + wr * 64 + m * 16 + fr; const f32x4 q = *(const LAS f32x4*)(MX + r * 4); const float M = fmaxf(fmaxf(q[0], q[1]), fmaxf(q[2], q[3])); float s = 0.f;
#pragma unroll
                for (int bj = 0; bj < 2; ++bj)
#pragma unroll
                    for (int n = 0; n < 2; ++n) { f32x4 v = acc[ai][bj][m][n];
#pragma unroll
                        for (int j = 0; j < 4; ++j) { v[j] = __builtin_amdgcn_exp2f(v[j] - M); s += v[j]; }
                        acc[ai][bj][m][n] = v; }
                s += __shfl_xor(s, 16); s += __shfl_xor(s, 32);
                if (fq == 0) SM[r * 4 + wc] = s; }
        asm volatile("s_waitcnt lgkmcnt(0)" ::: "memory"); __builtin_amdgcn_s_barrier(); asm volatile("" ::: "memory");
        const int col0 = u.pn * BM + wc * 32 + 8 * fq;
#pragma unroll
        for (int ai = 0; ai < 2; ++ai)
#pragma unroll
            for (int m = 0; m < 4; ++m) { const int r = ai * HALF + wr * 64 + m * 16 + fr; const f32x4 q = *(const LAS f32x4*)(SM + r * 4); const float inv = 1.0f / ((q[0] + q[1]) + (q[2] + q[3]));
                bf16_t* rowp = Pm + (size_t)(u.pm * BM + r) * 1024 + col0;
#pragma unroll
                for (int bj = 0; bj < 2; ++bj) { const f32x4 v0 = acc[ai][bj][m][0] * inv, v1 = acc[ai][bj][m][1] * inv;
                    u32x4 w; w.x = cvt_pk_bf16(v0[0], v0[1]); w.y = cvt_pk_bf16(v0[2], v0[3]); w.z = cvt_pk_bf16(v1[0], v1[1]); w.w = cvt_pk_bf16(v1[2], v1[3]);
                    *(u32x4*)(rowp + bj * HALF) = w; } }
    }
};
struct QkVoPtrs {
    const char* kcvc; const char* wcq; const char* wcoT; int K, lda, ldb;
    __device__ __forceinline__ const char* a(const Unit& u) const { const int L = u.pm; if (L < 256) { const int bh = L >> 4, b = bh >> 2, h = bh & 3; return kcvc + ((size_t)(b * 256) * 8192 + h * 1024) * 2; }
        const int L2 = L - 256, bh = L2 >> 4, h = bh & 3, nt = L2 & 15; return wcoT + ((size_t)(nt * 256) * 4096 + h * 1024) * 2; }
    __device__ __forceinline__ const char* b(const Unit& u) const { const int L = u.pm; if (L < 256) { const int bh = L >> 4, h = bh & 3, kt = L & 15; return wcq + ((size_t)(kt * 256) * 4096 + h * 1024) * 2; }
        const int L2 = L - 256, bh = L2 >> 4, b = bh >> 2, h = bh & 3; return kcvc + ((size_t)(b * 256) * 8192 + 4096 + h * 1024) * 2; }
};
struct EpiQkVo {
    static constexpr bool PERM = true, AFTER_DRAIN = false;
    bf16_t* WqkT; bf16_t* WvoT;
    __device__ __forceinline__ void operator()(const f32x4 (&acc)[2][2][4][2], const Unit& u, int wr, int wc, int fr, int fq) const {
        const int L = u.pm; bf16_t* base; int ldc;
        if (L < 256) { const int bh = L >> 4, b = bh >> 2, h = bh & 3, kt = L & 15; base = WqkT + ((size_t)(b * 1024 + h * 256)) * 4096 + kt * 256; ldc = 4096; }
        else { const int L2 = L - 256, bh = L2 >> 4, b = bh >> 2, h = bh & 3, nt = L2 & 15; base = WvoT + ((size_t)b * 4096 + nt * 256) * 1024 + h * 256; ldc = 1024; }
        const int row0 = wr * 64 + fr, col0 = wc * 32 + 8 * fq;
#pragma unroll
        for (int ai = 0; ai < 2; ++ai)
#pragma unroll
            for (int m = 0; m < 4; ++m) { bf16_t* rowp = base + (size_t)(row0 + ai * HALF + m * 16) * ldc + col0;
#pragma unroll
                for (int bj = 0; bj < 2; ++bj) { const f32x4 v0 = acc[ai][bj][m][0], v1 = acc[ai][bj][m][1];
                    u32x4 w; w.x = cvt_pk_bf16(v0[0], v0[1]); w.y = cvt_pk_bf16(v0[2], v0[3]); w.z = cvt_pk_bf16(v1[0], v1[1]); w.w = cvt_pk_bf16(v1[2], v1[3]);
                    *(u32x4*)(rowp + bj * HALF) = w; } }
    }
};
}

namespace mb {
constexpr int D = 128, NW = 8, QBLK = 32, KVBLK = 64, QB = NW * QBLK;
constexpr int SHM_V = KVBLK * D * 2, SHM_K = KVBLK * D * 2;
constexpr int KM_OFF = 2 * SHM_V + 2 * SHM_K + NW * 64 * 4;
constexpr int ATT_LDS = KM_OFF + 8192;
constexpr int OSTG_OFF = 77824;
constexpr int LDQ = 128, LDO = DM;
constexpr float SCALE = 0.08838834764831845f;
constexpr float THR = 8.f;
#define KSWZ(row, colB) ((row) * 256 + ((colB) ^ (((row) & 7) << 4)))
#define SBAR() __builtin_amdgcn_sched_barrier(0)
__device__ __forceinline__ int v_st(int k, int c) { const int kk = (k & ~0xC) | ((k & 4) << 1) | ((k & 8) >> 1); return ((kk >> 3) * 4 + (c >> 5)) * 512 + ((kk & 7) * 32 + (c & 31)) * 2; }
__device__ __forceinline__ int v_rd_base(int lane) { return ((lane & 3) << 3) | (((lane >> 2) & 3) << 6) | (((lane >> 4) & 1) << 5) | (((lane >> 5) & 1) << 8); }
constexpr int v_rd_off(int d0, int ks, int half) { return d0 * 512 + ks * 4096 + half * 2048; }
__device__ __forceinline__ int crow(int r, int hi) { return (r & 3) + 8 * (r >> 2) + 4 * hi; }
__device__ __forceinline__ bf16x8 load8(const bf16_t* p) { return *reinterpret_cast<const bf16x8*>(p); }
__device__ __forceinline__ void mask_causal(f32x16& p0, f32x16& p1, int dq) {
    const float NEG = -__builtin_inff();
#pragma unroll
    for (int r = 0; r < 16; ++r) {
        const int c = (r & 3) + 8 * (r >> 2);
        if (dq - c < 0) p0[r] = NEG;
        if (dq - c - 32 < 0) p1[r] = NEG;
    }
}
__device__ __forceinline__ void partialSM(f32x16& p0, f32x16& p1, float& m_reg, float& mn, float& alpha, bool allow) {
    float pmax = p0[0];
#pragma unroll
    for (int r = 1; r < 16; ++r) pmax = fmaxf(pmax, p0[r]);
#pragma unroll
    for (int r = 0; r < 16; ++r) pmax = fmaxf(pmax, p1[r]);
    { auto rr = __builtin_amdgcn_permlane32_swap(__float_as_uint(pmax), __float_as_uint(pmax), false, false);
      pmax = fmaxf(__uint_as_float(rr[0]), __uint_as_float(rr[1])); }
    pmax = allow ? pmax : -__builtin_inff();
    constexpr float C2 = 1.4426950408889634f * SCALE;
    if (__builtin_expect(__all((pmax - m_reg) * SCALE <= THR), 1)) { mn = m_reg; alpha = 1.f; }
    else { mn = fmaxf(m_reg, pmax); alpha = __builtin_amdgcn_exp2f((m_reg - mn) * C2); m_reg = mn; }
    const float mnL = allow ? -mn * C2 : -__builtin_inff();
#pragma unroll
    for (int r = 0; r < 16; ++r) p0[r] = fmaf(p0[r], C2, mnL);
#pragma unroll
    for (int r = 0; r < 16; ++r) p1[r] = fmaf(p1[r], C2, mnL);
#pragma unroll
    for (int r = 0; r < 16; ++r) p0[r] = __builtin_amdgcn_exp2f(p0[r]);
}
__device__ __forceinline__ void finishSM(f32x16& p0, f32x16& p1, float alpha, float& l_reg, bf16x8& pa0, bf16x8& pa1, bf16x8& pa2, bf16x8& pa3) {
#pragma unroll
    for (int r = 0; r < 16; ++r) p1[r] = __builtin_amdgcn_exp2f(p1[r]);
    float ps = 0;
#pragma unroll
    for (int r = 0; r < 16; ++r) ps += p0[r];
#pragma unroll
    for (int r = 0; r < 16; ++r) ps += p1[r];
    { auto rr = __builtin_amdgcn_permlane32_swap(__float_as_uint(ps), __float_as_uint(ps), false, false);
      ps = __uint_as_float(rr[0]) + __uint_as_float(rr[1]); }
    l_reg = l_reg * alpha + ps;
#define PK4(P, B_, OUT) do { unsigned a0 = cvt_pk_bf16(P[B_+0], P[B_+1]), a1 = cvt_pk_bf16(P[B_+2], P[B_+3]);                          \
        unsigned b0 = cvt_pk_bf16(P[B_+4], P[B_+5]), b1 = cvt_pk_bf16(P[B_+6], P[B_+7]);                                             \
        auto r0 = __builtin_amdgcn_permlane32_swap(a0, b0, false, false); auto r1 = __builtin_amdgcn_permlane32_swap(a1, b1, false, false); \
        u32x4 w = {r0[0], r1[0], r0[1], r1[1]}; OUT = *reinterpret_cast<bf16x8*>(&w); } while (0)
    PK4(p0, 0, pa0); PK4(p0, 8, pa1); PK4(p1, 0, pa2); PK4(p1, 8, pa3);
#undef PK4
}
template <int KB>
__device__ __forceinline__ void qkt(f32x16& p0, f32x16& p1, const char* K_lds, int r32, int hi, const bf16x8* qr) {
    p0 = f32x16{}; p1 = f32x16{};
    const char* kb[4];
#pragma unroll
    for (int dd = 0; dd < 4; ++dd) kb[dd] = K_lds + KB * SHM_K + KSWZ(r32, (dd * 16 + hi * 8) * 2);
#pragma unroll
    for (int d0 = 0; d0 < 8; ++d0) { const char* a = kb[d0 & 3] + (d0 >> 2) * 128;
        bf16x8 b0 = *reinterpret_cast<const bf16x8*>(a);
        bf16x8 b1 = *reinterpret_cast<const bf16x8*>(a + 32 * 256);
        p0 = mfma32_h(b0, qr[d0], p0);
        p1 = mfma32_h(b1, qr[d0], p1); }
}
template <int VB>
__device__ __forceinline__ void pv_tile(f32x16* o, int vb0, bf16x8 pa0, bf16x8 pa1, bf16x8 pa2, bf16x8 pa3) {
#define TRRD(dst, off) asm volatile("ds_read_b64_tr_b16 %0, %1 offset:%2" : "=&v"(dst) : "v"(vb0), "i"(off) : "memory")
#define PV_D0(d0) do { s16x4 l0, l1, l2, l3, h0, h1, h2, h3; constexpr int b_ = VB * SHM_V + v_rd_off(d0, 0, 0); \
        TRRD(l0, b_); TRRD(h0, b_ + 2048); TRRD(l1, b_ + 4096); TRRD(h1, b_ + 6144); TRRD(l2, b_ + 8192); TRRD(h2, b_ + 10240); TRRD(l3, b_ + 12288); TRRD(h3, b_ + 14336); \
        asm volatile("s_waitcnt lgkmcnt(0)" ::: "memory"); SBAR();   \
        o[d0] = mfma32_h(pa0, (bf16x8){l0[0], l0[1], l0[2], l0[3], h0[0], h0[1], h0[2], h0[3]}, o[d0]);   \
        o[d0] = mfma32_h(pa1, (bf16x8){l1[0], l1[1], l1[2], l1[3], h1[0], h1[1], h1[2], h1[3]}, o[d0]);   \
        o[d0] = mfma32_h(pa2, (bf16x8){l2[0], l2[1], l2[2], l2[3], h2[0], h2[1], h2[2], h2[3]}, o[d0]);   \
        o[d0] = mfma32_h(pa3, (bf16x8){l3[0], l3[1], l3[2], l3[3], h3[0], h3[1], h3[2], h3[3]}, o[d0]); } while (0)
    PV_D0(0); PV_D0(1); PV_D0(2); PV_D0(3);
#undef PV_D0
#undef TRRD
}
struct BlockRef { const bf16_t* Q; const bf16_t* K; const bf16_t* V; bf16_t* O; const float* km; int qb; };
struct Seam { bf16x8 qr[8]; bf16x8 st_v0, st_v1, st_k0, st_k1; };
#define ROWU(p, k0, half) ((const bf16_t*)((const char*)(p) + (size_t)((k0) + (half) * 32) * (LDQ * 2) + lane_ld))
#define VMW() asm volatile("s_waitcnt vmcnt(0)" ::: "memory")
#define VMWN(n) asm volatile("s_waitcnt vmcnt(%0)" :: "i"(n) : "memory")
#define SLOAD_H(Kp, Vp, k0) do { S.st_v0 = load8(ROWU(Vp, k0, 0)); S.st_v1 = load8(ROWU(Vp, k0, 1));              \
                         S.st_k0 = load8(ROWU(Kp, k0, 0)); S.st_k1 = load8(ROWU(Kp, k0, 1)); } while (0)
#define SWRITE_HK(bf) do { *(bf16x8*)(K_lds + (bf) * SHM_K + kws) = S.st_k0; *(bf16x8*)(K_lds + (bf) * SHM_K + kws + 32 * 256) = S.st_k1; } while (0)
#define SWRITE_HV(bf) do { *(bf16x8*)(V_lds + (bf) * SHM_V + vst0) = S.st_v0; *(bf16x8*)(V_lds + (bf) * SHM_V + vst1) = S.st_v1; } while (0)
#define SWRITE_H(bf) do { SWRITE_HV(bf); SWRITE_HK(bf); } while (0)
__device__ __forceinline__ void moba_prime(const BlockRef& cur, char* lds, Seam& S) {
    int tid_ = threadIdx.x; asm volatile("" : "+v"(tid_));
    const int tid = tid_, wid = __builtin_amdgcn_readfirstlane(tid >> 6), lane = tid & 63, r32 = lane & 31, hi = lane >> 5;
    const int sr = tid >> 4, sc = (tid & 15) * 8, kws = KSWZ(sr, sc * 2); char* K_lds = lds + 2 * SHM_V;
    const unsigned lane_ld = (unsigned)((sr * LDQ + sc) * 2);
#pragma unroll
    for (int d0 = 0; d0 < 8; ++d0) S.qr[d0] = load8(cur.Q + (size_t)(wid * QBLK + r32) * LDQ + d0 * 16 + hi * 8);
    SLOAD_H(cur.K, cur.V, 0); VMW(); SWRITE_HK(0);
    __syncthreads();
}
__device__ __forceinline__ void moba_block(const BlockRef& cur, const BlockRef& nxt, char* lds, Seam& S) {
    int tid_ = threadIdx.x; asm volatile("" : "+v"(tid_));
    const int tid = tid_, wid = __builtin_amdgcn_readfirstlane(tid >> 6), lane = tid & 63, r32 = lane & 31, hi = lane >> 5;
    const int qb = cur.qb, P0 = qb * QB;
    const int NT = (P0 + QB) / KVBLK;
    const int qlo = P0 + wid * QBLK, qm = qlo + r32 - 4 * hi;
    char* V_lds = lds; char* K_lds = lds + 2 * SHM_V;
    float* ws = (float*)(lds + 2 * SHM_V + 2 * SHM_K) + wid * 64; float* li_l = ws, * al_l = ws + 32;
    float* KM = (float*)(lds + KM_OFF);
    *(f32x4*)(KM + tid * 4) = *(const f32x4*)(cur.km + tid * 4);
    __syncthreads();
    unsigned mrow;
    if (qb <= 3) mrow = (2u << qb) - 1u;
    else {
        float g[15];
#pragma unroll
        for (int n = 0; n < 15; ++n) { g[n] = -__builtin_inff();
            if (n < qb) { float a = 0.f; const float* km = KM + n * 128 + hi * 8;
#pragma unroll
                for (int d0 = 0; d0 < 8; ++d0) { const bf16x8 q = S.qr[d0]; const f32x4 k0 = *(const f32x4*)(km + d0 * 16), k1 = *(const f32x4*)(km + d0 * 16 + 4);
                    a += bf2f((unsigned short)q[0]) * k0[0]; a += bf2f((unsigned short)q[1]) * k0[1]; a += bf2f((unsigned short)q[2]) * k0[2]; a += bf2f((unsigned short)q[3]) * k0[3];
                    a += bf2f((unsigned short)q[4]) * k1[0]; a += bf2f((unsigned short)q[5]) * k1[1]; a += bf2f((unsigned short)q[6]) * k1[2]; a += bf2f((unsigned short)q[7]) * k1[3]; }
                a += __shfl_xor(a, 32); g[n] = a; } }
        unsigned taken = 0u;
#pragma unroll
        for (int rep = 0; rep < 3; ++rep) { float best = -__builtin_inff(); int bi = 0;
#pragma unroll
            for (int n = 0; n < 15; ++n) { const bool c = (g[n] > best); best = c ? g[n] : best; bi = c ? n : bi; }
            taken |= 1u << bi;
#pragma unroll
            for (int n = 0; n < 15; ++n) g[n] = (n == bi) ? -__builtin_inff() : g[n]; }
        mrow = taken | (1u << qb);
    }
    float m_reg = -1e30f, l_reg = 0; f32x16 o[4] = {};
    const int sr = tid >> 4, sc = (tid & 15) * 8, vst0 = v_st(sr, sc), vst1 = v_st(32 + sr, sc), kws = KSWZ(sr, sc * 2);
    const unsigned lane_ld = (unsigned)((sr * LDQ + sc) * 2);
    const int vb0 = (int)(uintptr_t)V_lds + v_rd_base(lane);
    const bf16_t* Kh = cur.K; const bf16_t* Vh = cur.V;
#define RESC(a) do { if (__any((a) < 1.f)) { if (hi == 0) al_l[r32] = (a); asm volatile("s_waitcnt lgkmcnt(0)" ::: "memory");              \
                     for (int d_ = 0; d_ < 4; ++d_) for (int r = 0; r < 16; ++r) o[d_][r] *= al_l[crow(r, hi)]; } } while (0)
#define KBASE(t) ((t) * KVBLK)
#define MASKT(P0_, P1_, t) do { if (((t) >> 2) == qb) { if (KBASE(t) + KVBLK - 1 > qlo) mask_causal(P0_, P1_, qm - KBASE(t)); } } while (0)
#define ALLOWT(t) (((mrow >> ((t) >> 2)) & 1u) != 0u)
    constexpr int NQL = 8;
#define SEAM_K0() do { VMWN(NQL); SWRITE_HK(0); SBAR(); } while (0)
    f32x16 pA0, pA1, pB0, pB1; float mnA, mnB, alA, alB; bf16x8 pa0, pa1, pa2, pa3;
    SWRITE_HV(0); SBAR();
    if (NT > 1) SLOAD_H(Kh, Vh, KBASE(1));
    SBAR(); qkt<0>(pA0, pA1, K_lds, r32, hi, S.qr);
    MASKT(pA0, pA1, 0); partialSM(pA0, pA1, m_reg, mnA, alA, ALLOWT(0));
    if (NT > 1) { VMW(); SWRITE_H(1); }
    __syncthreads();
#define HALF_STEP(PX0, PX1, mnX, alX, PY0, PY1, alY, t, KB, VB, SB) do {                                                      \
        SBAR(); qkt<KB>(PX0, PX1, K_lds, r32, hi, S.qr);                                             \
        finishSM(PY0, PY1, alY, l_reg, pa0, pa1, pa2, pa3); SBAR();                                                           \
        if ((t) + 1 < NT) { SLOAD_H(Kh, Vh, KBASE((t) + 1)); SBAR(); }                                               \
        pv_tile<VB>(o, vb0, pa0, pa1, pa2, pa3); MASKT(PX0, PX1, (t)); partialSM(PX0, PX1, m_reg, mnX, alX, ALLOWT(t));                                        \
        __syncthreads();                                                                                                      \
        if ((t) + 1 < NT) { VMW(); SWRITE_H(SB); }                                                                          \
        RESC(alX); __syncthreads(); } while (0)
    if (wid >= 4) __builtin_amdgcn_s_setprio(1);
    for (int t = 1; t + 1 < NT; t += 2) {
        HALF_STEP(pB0, pB1, mnB, alB, pA0, pA1, alA, t, 1, 0, 0);
        HALF_STEP(pA0, pA1, mnA, alA, pB0, pB1, alB, t + 1, 0, 1, 1);
    }
    __builtin_amdgcn_s_setprio(0);
    SBAR(); qkt<1>(pB0, pB1, K_lds, r32, hi, S.qr); SBAR();
    SLOAD_H(nxt.K, nxt.V, 0); SBAR();
#pragma unroll
    for (int d0 = 0; d0 < 8; ++d0) S.qr[d0] = load8(nxt.Q + (size_t)(wid * QBLK + r32) * LDQ + d0 * 16 + hi * 8);
    SBAR();
    finishSM(pA0, pA1, alA, l_reg, pa0, pa1, pa2, pa3); SBAR();
    pv_tile<0>(o, vb0, pa0, pa1, pa2, pa3);
    MASKT(pB0, pB1, NT - 1); partialSM(pB0, pB1, m_reg, mnB, alB, true); __syncthreads(); RESC(alB);
    finishSM(pB0, pB1, alB, l_reg, pa0, pa1, pa2, pa3); SBAR(); pv_tile<1>(o, vb0, pa0, pa1, pa2, pa3);
    SBAR(); SEAM_K0();
    if (hi == 0) li_l[r32] = l_reg; asm volatile("s_waitcnt lgkmcnt(0)" ::: "memory");
    float rli[16];
#pragma unroll
    for (int r = 0; r < 16; ++r) rli[r] = __builtin_amdgcn_rcpf(li_l[crow(r, hi)]);
    char* Ow = (char*)(cur.O + (size_t)(wid * QBLK) * LDO);
    char* stg = lds + OSTG_OFF + wid * 4608;
    unsigned st_w = (unsigned)(4 * hi * 144 + r32 * 2), st_r = (unsigned)((lane >> 3) * 144 + (lane & 7) * 16), g_off = (unsigned)((lane >> 3) * (LDO * 2) + (lane & 7) * 16);
    asm volatile("" : "+v"(st_w), "+v"(st_r), "+v"(g_off));
#pragma unroll
    for (int h2 = 0; h2 < 2; ++h2) {
#pragma unroll
        for (int r = 0; r < 16; ++r)
#pragma unroll
            for (int dd = 0; dd < 2; ++dd) { const float v = o[2 * h2 + dd][r] * rli[r]; const float vn = __shfl_xor(v, 1);
                if ((r32 & 1) == 0) *(unsigned*)(stg + ((r & 3) + 8 * (r >> 2)) * 144 + dd * 64 + st_w) = cvt_pk_bf16(v, vn); }
        asm volatile("s_waitcnt lgkmcnt(0)" ::: "memory");
#pragma unroll
        for (int j = 0; j < 4; ++j) { const u32x4 w = *(const u32x4*)(stg + j * 8 * 144 + st_r); *(u32x4*)(Ow + (size_t)j * 8 * (LDO * 2) + h2 * 128 + g_off) = w; }
        asm volatile("s_waitcnt lgkmcnt(0)" ::: "memory");
    }
    __syncthreads();
#undef RESC
#undef KBASE
#undef MASKT
#undef ALLOWT
#undef SEAM_K0
#undef HALF_STEP
}
#undef ROWU
#undef VMW
#undef VMWN
#undef SLOAD_H
#undef SWRITE_HK
#undef SWRITE_HV
#undef SWRITE_H
}


namespace gla {
constexpr int L_SEG = 0, L_BT = 2048;
constexpr int GA_E = 4096, GA_KI = 38912, GA_VT = 55296;
constexpr int L_QD = 4096, L_KI = L_QD + 17408, L_VT = 38912, L_AT = 71680, L_OT = 4096;
__device__ __forceinline__ int crow(int r, int hi) { return (r & 3) + 8 * (r >> 2) + 4 * hi; }
__device__ __forceinline__ unsigned short f2bf1(float x) { return (unsigned short)(cvt_pk_bf16(x, 0.f) & 0xffffu); }
#define GLA_TRRD(dst, base, off) asm volatile("ds_read_b64_tr_b16 %0, %1 offset:%2" : "=&v"(dst) : "v"(base), "i"(off) : "memory")
#define GLA_FRAG(dst, base, d0, ks) do { s16x4 l_, h_; GLA_TRRD(l_, base, (d0) * 512 + (ks) * 4096); GLA_TRRD(h_, base, (d0) * 512 + (ks) * 4096 + 2048); \
        asm volatile("s_waitcnt lgkmcnt(0)" ::: "memory"); __builtin_amdgcn_sched_barrier(0); dst = (bf16x8){l_[0], l_[1], l_[2], l_[3], h_[0], h_[1], h_[2], h_[3]}; } while (0)
__device__ __forceinline__ float prep_b(LAS unsigned char* lds, const float* glow_rows, const float (&wg)[16], float bg, int k, int seg, float (&bv)[16]) {
    float cum = 0.f;
#pragma unroll
    for (int j = 0; j < 16; ++j) { const float* gl = glow_rows + (16 * seg + j) * 16; float z = bg;
#pragma unroll
        for (int r = 0; r < 16; ++r) z += gl[r] * wg[r];
        const float ls = fminf(z, 0.f) - __logf(1.0f + __expf(-fabsf(z)));
        cum += ls * (1.0f / 16.0f); bv[j] = cum; }
    LAS float* SEG = (LAS float*)(lds + L_SEG);
    SEG[seg * 128 + k] = cum;
    __syncthreads();
    float pre = 0.f, tot = 0.f;
#pragma unroll
    for (int s2 = 0; s2 < 4; ++s2) { const float v = SEG[s2 * 128 + k]; tot += v; pre += (s2 < seg) ? v : 0.f; }
#pragma unroll
    for (int j = 0; j < 16; ++j) bv[j] += pre;
    if (seg == 0) ((LAS float*)(lds + L_BT))[k] = __expf(tot);
    return tot;
}
__device__ __forceinline__ void load_v(u32x4 (&vr)[4], const bf16_t* vsrc, int tid) {
    const int t = tid >> 3, v0 = (tid & 7) * 32;
#pragma unroll
    for (int j = 0; j < 4; ++j) vr[j] = *(const u32x4*)(vsrc + (size_t)t * PROJ_LD + v0 + 8 * j);
}
__device__ __forceinline__ void store_v(LAS unsigned char* lds, int off, const u32x4 (&vr)[4], int tid) {
    const int t = tid >> 3, v0 = (tid & 7) * 32;
#pragma unroll
    for (int j = 0; j < 4; ++j) { const int c = v0 + 8 * j; *(LAS u32x4*)(lds + off + (c >> 7) * 16384 + mb::v_st(t, c & 127)) = vr[j]; }
}
__device__ __forceinline__ void ga_unit(LAS unsigned char* lds, int unit, bf16_t* proj, const float* glow, const float* w_gate_up, const float* b_gate, bf16_t* dSt, float* decay, int tid, int wave, int lane) {
    const int n = unit & 63, bh = unit >> 6, b = bh >> 3, h = bh & 7;
    const size_t row0 = (size_t)b * SEQ + n * 64;
    const int k = tid & 127, seg = __builtin_amdgcn_readfirstlane(tid >> 7);
    const int t = tid >> 3, c0 = (tid & 7) * 16;
    bf16_t* qp = proj + (row0 + t) * PROJ_LD + C_GQ + h * 128 + c0; bf16_t* kp = qp + (C_GK - C_GQ);
    const u32x4 q0 = *(const u32x4*)qp, q1 = *(const u32x4*)(qp + 8), k0 = *(const u32x4*)kp, k1 = *(const u32x4*)(kp + 8);
    u32x4 vr[4]; load_v(vr, proj + row0 * PROJ_LD + C_GV + h * 256, tid);
    float wg[16];
#pragma unroll
    for (int r = 0; r < 16; ++r) wg[r] = w_gate_up[r * 1024 + h * 128 + k];
    float bv[16];
    const float tot = prep_b(lds, glow + row0 * 16, wg, b_gate[h * 128 + k], k, seg, bv);
#pragma unroll
    for (int j = 0; j < 16; ++j) *(LAS float*)(lds + GA_E + ((16 * seg + j) * 132 + k) * 4) = __expf(bv[j]);
    if (seg == 0) decay[(size_t)unit * 128 + k] = __expf(tot);
    store_v(lds, GA_VT, vr, tid);
    __syncthreads();
    {
        const LAS f32x4* ep = (const LAS f32x4*)(lds + GA_E + (t * 132 + c0) * 4); f32x4 e[4];
#pragma unroll
        for (int i = 0; i < 4; ++i) e[i] = ep[i];
        const unsigned qw[8] = {q0.x, q0.y, q0.z, q0.w, q1.x, q1.y, q1.z, q1.w}, kw[8] = {k0.x, k0.y, k0.z, k0.w, k1.x, k1.y, k1.z, k1.w}; unsigned qo[8], ko[8];
#pragma unroll
        for (int i = 0; i < 8; ++i) { const float e0 = e[i >> 1][(i & 1) * 2], e1 = e[i >> 1][(i & 1) * 2 + 1];
            qo[i] = cvt_pk_bf16(bflo(qw[i]) * 0.08838834764831845f * e0, bfhi(qw[i]) * 0.08838834764831845f * e1);
            ko[i] = cvt_pk_bf16(bflo(kw[i]) * __builtin_amdgcn_rcpf(e0), bfhi(kw[i]) * __builtin_amdgcn_rcpf(e1)); }
        const u32x4 qa = {qo[0], qo[1], qo[2], qo[3]}, qb = {qo[4], qo[5], qo[6], qo[7]}, ka = {ko[0], ko[1], ko[2], ko[3]}, kb = {ko[4], ko[5], ko[6], ko[7]};
        *(u32x4*)qp = qa; *(u32x4*)(qp + 8) = qb; *(u32x4*)kp = ka; *(u32x4*)(kp + 8) = kb;
        *(LAS u32x4*)(lds + GA_KI + mb::v_st(t, c0)) = ka; *(LAS u32x4*)(lds + GA_KI + mb::v_st(t, c0 + 8)) = kb;
    }
    __syncthreads();
    const int r = lane & 31, hh = lane >> 5;
    const int kbase = (int)(uintptr_t)(lds + GA_KI) + mb::v_rd_base(lane), vbase = (int)(uintptr_t)(lds + GA_VT + (wave >> 2) * 16384) + mb::v_rd_base(lane);
    bf16x8 vf[4];
    switch (wave & 3) {
        case 0: GLA_FRAG(vf[0], vbase, 0, 0); GLA_FRAG(vf[1], vbase, 0, 1); GLA_FRAG(vf[2], vbase, 0, 2); GLA_FRAG(vf[3], vbase, 0, 3); break;
        case 1: GLA_FRAG(vf[0], vbase, 1, 0); GLA_FRAG(vf[1], vbase, 1, 1); GLA_FRAG(vf[2], vbase, 1, 2); GLA_FRAG(vf[3], vbase, 1, 3); break;
        case 2: GLA_FRAG(vf[0], vbase, 2, 0); GLA_FRAG(vf[1], vbase, 2, 1); GLA_FRAG(vf[2], vbase, 2, 2); GLA_FRAG(vf[3], vbase, 2, 3); break;
        default: GLA_FRAG(vf[0], vbase, 3, 0); GLA_FRAG(vf[1], vbase, 3, 1); GLA_FRAG(vf[2], vbase, 3, 2); GLA_FRAG(vf[3], vbase, 3, 3); break;
    }
    bf16_t* ob = dSt + ((size_t)unit * 256 + 32 * wave + r) * 128 + 8 * hh;
#define GA_KB(kb_) do { f32x16 acc = {}; bf16x8 kf; \
        GLA_FRAG(kf, kbase, kb_, 0); acc = mfma32_h(kf, vf[0], acc); GLA_FRAG(kf, kbase, kb_, 1); acc = mfma32_h(kf, vf[1], acc); \
        GLA_FRAG(kf, kbase, kb_, 2); acc = mfma32_h(kf, vf[2], acc); GLA_FRAG(kf, kbase, kb_, 3); acc = mfma32_h(kf, vf[3], acc); \
          \
        u32x2 w[4]; \
        _Pragma("unroll") for (int g4 = 0; g4 < 4; ++g4) { const f32x4 dk = *(const LAS f32x4*)(lds + L_BT + ((kb_) * 32 + 8 * g4 + 4 * hh) * 4); \
            w[g4].x = cvt_pk_bf16(acc[4 * g4] * dk[0], acc[4 * g4 + 1] * dk[1]); w[g4].y = cvt_pk_bf16(acc[4 * g4 + 2] * dk[2], acc[4 * g4 + 3] * dk[3]); } \
        _Pragma("unroll") for (int p = 0; p < 2; ++p) { auto rx = __builtin_amdgcn_permlane32_swap(w[2 * p].x, w[2 * p + 1].x, false, false); auto ry = __builtin_amdgcn_permlane32_swap(w[2 * p].y, w[2 * p + 1].y, false, false); \
            u32x4 o4 = {rx[0], ry[0], rx[1], ry[1]}; *(u32x4*)(ob + (kb_) * 32 + 16 * p) = o4; } } while (0)
    GA_KB(0); GA_KB(1); GA_KB(2); GA_KB(3);
#undef GA_KB
    __syncthreads();
}
__device__ __forceinline__ void gc_unit(LAS unsigned char* lds, int unit, const bf16_t* proj, const bf16_t* dSt, const float* gnorm, bf16_t* omix, int tid, int wave, int lane) {
    const int n = unit & 63, bh = unit >> 6, b = bh >> 3, h = bh & 7;
    const size_t row0 = (size_t)b * SEQ + n * 64;
    bf16x8 sfr[8];
    { const bf16_t* sp = dSt + ((size_t)unit * 256 + 32 * wave + (lane & 31)) * 128 + (lane >> 5) * 8;
#pragma unroll
      for (int ks = 0; ks < 8; ++ks) sfr[ks] = *(const bf16x8*)(sp + ks * 16); }
    { const int t = tid >> 3, c0 = (tid & 7) * 16; const bf16_t* qp = proj + (row0 + t) * PROJ_LD + C_GQ + h * 128 + c0;
      const u32x4 q0 = *(const u32x4*)qp, q1 = *(const u32x4*)(qp + 8), k0 = *(const u32x4*)(qp + (C_GK - C_GQ)), k1 = *(const u32x4*)(qp + (C_GK - C_GQ) + 8);
      u32x4 vr[4]; load_v(vr, proj + row0 * PROJ_LD + C_GV + h * 256, tid);
      *(LAS u32x4*)(lds + L_QD + t * 272 + c0 * 2) = q0; *(LAS u32x4*)(lds + L_QD + t * 272 + c0 * 2 + 16) = q1;
      *(LAS u32x4*)(lds + L_KI + t * 272 + c0 * 2) = k0; *(LAS u32x4*)(lds + L_KI + t * 272 + c0 * 2 + 16) = k1;
      store_v(lds, L_VT, vr, tid); }
    __syncthreads();
    const int r = lane & 31, hh = lane >> 5;
    if (wave < 4) { const int ct = wave & 1, st = wave >> 1; f32x16 acc = {};
#pragma unroll
        for (int ks = 0; ks < 8; ++ks) { const bf16x8 a = *(const LAS bf16x8*)(lds + L_QD + (ct * 32 + r) * 272 + ks * 32 + hh * 16), bb = *(const LAS bf16x8*)(lds + L_KI + (st * 32 + r) * 272 + ks * 32 + hh * 16);
            acc = mfma32_h(a, bb, acc); }
#pragma unroll
        for (int i = 0; i < 16; ++i) { const int c = ct * 32 + crow(i, hh), s2 = st * 32 + r; const float val = (s2 <= c) ? acc[i] : 0.f;
            *(LAS unsigned short*)(lds + L_AT + c * 144 + s2 * 2) = f2bf1(val); } }
    __syncthreads();
    f32x16 o0 = {}, o1 = {};
    { const int vbase = (int)(uintptr_t)(lds + L_VT + (wave >> 2) * 16384) + mb::v_rd_base(lane); bf16x8 vf[4];
      switch (wave & 3) {
          case 0: GLA_FRAG(vf[0], vbase, 0, 0); GLA_FRAG(vf[1], vbase, 0, 1); GLA_FRAG(vf[2], vbase, 0, 2); GLA_FRAG(vf[3], vbase, 0, 3); break;
          case 1: GLA_FRAG(vf[0], vbase, 1, 0); GLA_FRAG(vf[1], vbase, 1, 1); GLA_FRAG(vf[2], vbase, 1, 2); GLA_FRAG(vf[3], vbase, 1, 3); break;
          case 2: GLA_FRAG(vf[0], vbase, 2, 0); GLA_FRAG(vf[1], vbase, 2, 1); GLA_FRAG(vf[2], vbase, 2, 2); GLA_FRAG(vf[3], vbase, 2, 3); break;
          default: GLA_FRAG(vf[0], vbase, 3, 0); GLA_FRAG(vf[1], vbase, 3, 1); GLA_FRAG(vf[2], vbase, 3, 2); GLA_FRAG(vf[3], vbase, 3, 3); break;
      }
#pragma unroll
      for (int ss = 0; ss < 4; ++ss) { const bf16x8 a0 = *(const LAS bf16x8*)(lds + L_AT + r * 144 + ss * 32 + hh * 16), a1 = *(const LAS bf16x8*)(lds + L_AT + (32 + r) * 144 + ss * 32 + hh * 16);
          o0 = mfma32_h(a0, vf[ss], o0); o1 = mfma32_h(a1, vf[ss], o1); } }
    {
#pragma unroll
      for (int ks = 0; ks < 8; ++ks) { const bf16x8 bb = sfr[ks];
          const bf16x8 a0 = *(const LAS bf16x8*)(lds + L_QD + r * 272 + ks * 32 + hh * 16), a1 = *(const LAS bf16x8*)(lds + L_QD + (32 + r) * 272 + ks * 32 + hh * 16);
          o0 = mfma32_h(a0, bb, o0); o1 = mfma32_h(a1, bb, o1); } }
    __syncthreads();
#pragma unroll
    for (int i = 0; i < 16; ++i) { const int c = crow(i, hh); *(LAS float*)(lds + L_OT + c * 1040 + (32 * wave + r) * 4) = o0[i]; *(LAS float*)(lds + L_OT + (32 + c) * 1040 + (32 * wave + r) * 4) = o1[i]; }
    __syncthreads();
    const f32x4 g = *((const f32x4*)gnorm + lane);
#pragma unroll
    for (int rr = 0; rr < 8; ++rr) { const int c = 8 * wave + rr; const f32x4 v = *(const LAS f32x4*)(lds + L_OT + c * 1040 + lane * 16);
        float ss = (v[0] * v[0] + v[1] * v[1]) + (v[2] * v[2] + v[3] * v[3]);
#pragma unroll
        for (int o = 1; o < 64; o <<= 1) ss += __shfl_xor(ss, o);
        const float rs = 1.0f / sqrtf(ss * (1.0f / 256.0f) + EPS);
        const u32x2 gw2 = *((const u32x2*)(proj + (row0 + c) * PROJ_LD + C_GOUT + h * 256) + lane);
        const float z0 = bflo(gw2.x), z1 = bfhi(gw2.x), z2 = bflo(gw2.y), z3 = bfhi(gw2.y);
        const float p0 = v[0] * rs * g[0] * (z0 / (1.0f + __expf(-z0))), p1 = v[1] * rs * g[1] * (z1 / (1.0f + __expf(-z1)));
        const float p2 = v[2] * rs * g[2] * (z2 / (1.0f + __expf(-z2))), p3 = v[3] * rs * g[3] * (z3 / (1.0f + __expf(-z3)));
        u32x2 w; w.x = cvt_pk_bf16(p0, p1); w.y = cvt_pk_bf16(p2, p3); *((u32x2*)(omix + (row0 + c) * DM + h * 256) + lane) = w; }
    __syncthreads();
}
#undef GLA_FRAG
#undef GLA_TRRD
}

constexpr int NWAVES = 8;
constexpr int RING_BYTES = 131072;
constexpr int LDSCTL_OFF = 143360, MISC_OFF = LDSCTL_OFF + 320;
constexpr int LDS_BYTES = 147456;
constexpr int CW_BAR = 4096;
constexpr int NPHASE = 14;

typedef GAS unsigned gu32;
#define RLX_AGENT __ATOMIC_RELAXED, __HIP_MEMORY_SCOPE_AGENT
#define LDS_WAIT() asm volatile("s_waitcnt lgkmcnt(0)" ::: "memory")
#define VM_WAIT() asm volatile("s_waitcnt vmcnt(0)" ::: "memory")

#define XB_TMO      128
#define XB_XCNT(j)  (256  + 64 * (j))
#define XB_XSUB(j)  (1280 + 64 * (j))
#define XB_XGEN(j)  (2304 + 64 * (j))
#define XB_TOP      3328
#define XB_TOPGEN   3392
#define XCD_BAR_WORDS 3456
#define XB_SPIN_CAP (1u << 18)
__device__ __forceinline__ unsigned xb_ld(unsigned* p)              { return __hip_atomic_load(p, __ATOMIC_RELAXED, __HIP_MEMORY_SCOPE_AGENT); }
__device__ __forceinline__ unsigned xb_add(unsigned* p, unsigned v) { return __hip_atomic_fetch_add(p, v, __ATOMIC_RELAXED, __HIP_MEMORY_SCOPE_AGENT); }
__device__ __forceinline__ unsigned xb_xcc_id() { return (unsigned)__builtin_amdgcn_s_getreg((3 << 11) | 20) & 0xFu; }
#define XB_SPIN(cond, bar) do { unsigned _sp = 0; while (cond) { __builtin_amdgcn_s_sleep(1); \
    if ((++_sp & 255u) == 0u) { if (xb_ld(&(bar)[XB_TMO])) break; if (_sp > XB_SPIN_CAP) { atomicAdd(&(bar)[XB_TMO], 1u); break; } } } } while (0)
struct XcdBarrier { unsigned* bar; unsigned x; volatile LAS unsigned* st; };
__device__ __forceinline__ XcdBarrier xcd_barrier_post(unsigned* bar, volatile LAS unsigned* st) {
    XcdBarrier b; b.bar = bar; b.x = xb_xcc_id(); b.st = st;
    if (threadIdx.x == 0) (void)xb_add(&bar[XB_XCNT(b.x)], 1u);
    return b;
}
__device__ __forceinline__ void xcd_barrier_complete(unsigned* bar, unsigned x, unsigned& nloc, unsigned& nx) {
    const unsigned G = gridDim.x * gridDim.y * gridDim.z;
    unsigned sum, cnt, mine, sp = 0u;
    for (;;) {
        sum = 0u; cnt = 0u; mine = 0u;
#pragma unroll
        for (unsigned j = 0; j < 16; ++j) { const unsigned c = xb_ld(&bar[XB_XCNT(j)]); sum += c; cnt += (c > 0u) ? 1u : 0u; mine = (j == x) ? c : mine; }
        if (sum == G) break;
        __builtin_amdgcn_s_sleep(1);
        if ((++sp & 255u) == 0u) { if (xb_ld(&bar[XB_TMO])) break; if (sp > XB_SPIN_CAP) { atomicAdd(&bar[XB_TMO], 1u); break; } }
    }
    nloc = mine > 0u ? mine : 1u; nx = cnt > 0u ? cnt : 1u;
}
__device__ __forceinline__ void xcd_barrier(const XcdBarrier& b) {
    asm volatile("s_waitcnt vmcnt(0)" ::: "memory");
    __syncthreads();
    if (threadIdx.x == 0) {
        unsigned* bar = b.bar;
        __builtin_amdgcn_s_waitcnt(0);
        unsigned nloc = b.st[0], nx = b.st[1];
        if (nloc == 0u) { xcd_barrier_complete(bar, b.x, nloc, nx); b.st[0] = nloc; b.st[1] = nx; }
        const unsigned old = xb_add(&bar[XB_XSUB(b.x)], 1u);
        const unsigned gen = old / nloc;
        if (old + 1u == (gen + 1u) * nloc) {
            __builtin_amdgcn_fence(__ATOMIC_RELEASE, "agent");
            asm volatile("s_waitcnt vmcnt(0)" ::: "memory");
            const unsigned og = xb_add(&bar[XB_TOP], 1u);
            const unsigned tg = og / nx;
            if (og + 1u == (tg + 1u) * nx) xb_add(&bar[XB_TOPGEN], 1u);
            else XB_SPIN(xb_ld(&bar[XB_TOPGEN]) == tg, bar);
            __builtin_amdgcn_fence(__ATOMIC_ACQUIRE, "agent");
            xb_add(&bar[XB_XGEN(b.x)], 1u);
            asm volatile("s_waitcnt vmcnt(0)" ::: "memory");
        } else {
            XB_SPIN(xb_ld(&bar[XB_XGEN(b.x)]) == gen, bar);
            __builtin_amdgcn_fence(__ATOMIC_ACQUIRE, "agent");
            asm volatile("s_waitcnt vmcnt(0)" ::: "memory");
        }
    }
    __syncthreads();
}

struct Frame {
    LAS unsigned char* lds; char* ldsg;
    int tid, lane, wave, vcu, G;
    unsigned char* ws;
    float* out;
};
__device__ __forceinline__ float wave_sum(float v) {
#pragma unroll
    for (int o = 1; o < 64; o <<= 1) v += __shfl_xor(v, o);
    return v;
}
__device__ __forceinline__ void p0_transpose_item(const float* W, int ldw, int K, const float* gain, bf16_t* WT, int nblk, int ncol_src0, int row_off, LAS float* scr, int item, int lane) {
    const int kb = item / nblk, nb = item % nblk, k0 = 64 * kb, n0 = 32 * nb;
#pragma unroll 8
    for (int i = 0; i < 32; ++i) { const int kk = 2 * i + (lane >> 5); float w = W[(size_t)(k0 + kk) * ldw + ncol_src0 + n0 + (lane & 31)]; if (gain) w *= gain[k0 + kk]; scr[kk * 33 + (lane & 31)] = w; }
    LDS_WAIT(); asm volatile("" ::: "memory");
    const int c = lane & 7;
#pragma unroll
    for (int j = 0; j < 4; ++j) { const int n = (lane >> 3) + 8 * j; const LAS float* s = scr + (8 * c) * 33 + n;
        u32x4 o; o.x = cvt_pk_bf16(s[0 * 33], s[1 * 33]); o.y = cvt_pk_bf16(s[2 * 33], s[3 * 33]); o.z = cvt_pk_bf16(s[4 * 33], s[5 * 33]); o.w = cvt_pk_bf16(s[6 * 33], s[7 * 33]);
        *(GAS u32x4*)(WT + (size_t)(row_off + n0 + n) * K + k0 + 8 * c) = o; }
    LDS_WAIT(); asm volatile("" ::: "memory");
}

__device__ __forceinline__ mb::BlockRef moba_ref(const bf16_t* qkvh, bf16_t* omix, const float* kmean, int Li, int pass) {
    mb::BlockRef r; const int bh = Li >> 3, xx = Li & 7, b = bh >> 4, h = bh & 15; const int qb = pass ? 15 - xx : xx;
    const bf16_t* base = qkvh + (size_t)bh * SEQ * 128;
    r.Q = base + (size_t)(qb * 256) * 128; r.K = base + QKVH_T; r.V = base + 2 * QKVH_T; r.O = omix + (size_t)(b * SEQ + qb * 256) * DM + 2048 + h * 128; r.km = kmean + (size_t)bh * 2048; r.qb = qb; return r;
}
__device__ __forceinline__ void p0_transpose64(const float* W, int ldw, int K, const float* gain, bf16_t* WT, int nblk, int ncol_src0, int row_off, LAS float* scr, int item, int lane) {
    const int kb = item / nblk, nb = item % nblk, k0 = 64 * kb, n0 = 64 * nb;
    const int c4 = (lane & 15) * 4, kr = lane >> 4;
    f32x4 w[16];
#pragma unroll
    for (int i = 0; i < 16; ++i) w[i] = __builtin_nontemporal_load((const f32x4*)(W + (size_t)(k0 + kr + 4 * i) * ldw + ncol_src0 + n0 + c4));
#pragma unroll
    for (int i = 0; i < 16; ++i) { f32x4 v = w[i]; if (gain) v = v * gain[k0 + kr + 4 * i]; *(LAS f32x4*)(scr + (kr + 4 * i) * 68 + c4) = v; }
    LDS_WAIT(); asm volatile("" ::: "memory");
#pragma unroll
    for (int j = 0; j < 8; ++j) { const int idx = lane + 64 * j, n = idx >> 3, c = idx & 7; const LAS float* sp = scr + (8 * c) * 68 + n;
        u32x4 o; o.x = cvt_pk_bf16(sp[0 * 68], sp[1 * 68]); o.y = cvt_pk_bf16(sp[2 * 68], sp[3 * 68]); o.z = cvt_pk_bf16(sp[4 * 68], sp[5 * 68]); o.w = cvt_pk_bf16(sp[6 * 68], sp[7 * 68]);
        *(GAS u32x4*)(WT + (size_t)(row_off + n0 + n) * K + k0 + 8 * c) = o; }
    LDS_WAIT(); asm volatile("" ::: "memory");
}
struct P0Item { const float* src; const float* gain; bf16_t* dst; int ldw, K; };
__device__ __forceinline__ P0Item p0_item(const float* W, int ldw, int K, const float* gain, bf16_t* WT, int nblk, int ncol_src0, int row_off, int item) {
    const int kb = item / nblk, nb = item % nblk, k0 = 64 * kb, n0 = 64 * nb; P0Item r;
    r.src = W + (size_t)k0 * ldw + ncol_src0 + n0; r.gain = gain ? gain + k0 : nullptr; r.dst = WT + (size_t)(row_off + n0) * K + k0; r.ldw = ldw; r.K = K; return r; }
__device__ __forceinline__ void p0_load(const P0Item& it, f32x4 (&w)[16], int lane) {
    const unsigned voff = (unsigned)(((lane >> 4) * it.ldw + (lane & 15) * 4) * 4);
#pragma unroll
    for (int i = 0; i < 16; ++i) w[i] = __builtin_nontemporal_load((const f32x4*)((const char*)(it.src + (size_t)(4 * i) * it.ldw) + voff));
}
__device__ __forceinline__ void p0_finish(const P0Item& it, const f32x4 (&w)[16], LAS float* scr, int lane) {
    const int c4 = (lane & 15) * 4, kr = lane >> 4;
    if (it.gain) { const unsigned goff = (unsigned)(kr * 4);
#pragma unroll
        for (int i = 0; i < 16; ++i) { const float g = *(const float*)((const char*)(it.gain + 4 * i) + goff); *(LAS f32x4*)(scr + (kr + 4 * i) * 68 + c4) = w[i] * g; } }
    else {
#pragma unroll
        for (int i = 0; i < 16; ++i) *(LAS f32x4*)(scr + (kr + 4 * i) * 68 + c4) = w[i]; }
    LDS_WAIT(); asm volatile("" ::: "memory");
    const unsigned soff = (unsigned)(((lane >> 3) * it.K + 8 * (lane & 7)) * 2);
#pragma unroll
    for (int j = 0; j < 8; ++j) { const int n = (lane >> 3) + 8 * j, c = lane & 7; const LAS float* sp = scr + (8 * c) * 68 + n;
        u32x4 o; o.x = cvt_pk_bf16(sp[0 * 68], sp[1 * 68]); o.y = cvt_pk_bf16(sp[2 * 68], sp[3 * 68]); o.z = cvt_pk_bf16(sp[4 * 68], sp[5 * 68]); o.w = cvt_pk_bf16(sp[6 * 68], sp[7 * 68]);
        *(GAS u32x4*)((char*)(it.dst + (size_t)(8 * j) * it.K) + soff) = o; }
    LDS_WAIT(); asm volatile("" ::: "memory");
}
template <class F> __device__ __forceinline__ void p0_pipe(int n, F desc, LAS float* scr, int lane) {
    P0Item a = desc(0), b = a; f32x4 w0[16], w1[16];
    p0_load(a, w0, lane);
    for (int j = 0; j < n; j += 2) {
        const bool hb_ = j + 1 < n; if (hb_) { b = desc(j + 1); p0_load(b, w1, lane); }
        p0_finish(a, w0, scr, lane);
        if (!hb_) break;
        if (j + 2 < n) { a = desc(j + 2); p0_load(a, w0, lane); }
        p0_finish(b, w1, scr, lane);
    }
}
__device__ __forceinline__ float absmax8(const u32x4 (&w)[8]) { float mx = 0.f;
#pragma unroll
    for (int j = 0; j < 8; ++j) mx = fmaxf(mx, fmaxf(fmaxf(fmaxf(fabsf(bflo(w[j].x)), fabsf(bfhi(w[j].x))), fmaxf(fabsf(bflo(w[j].y)), fabsf(bfhi(w[j].y)))), fmaxf(fmaxf(fabsf(bflo(w[j].z)), fabsf(bfhi(w[j].z))), fmaxf(fabsf(bflo(w[j].w)), fabsf(bfhi(w[j].w))))));
#pragma unroll
    for (int o = 1; o < 64; o <<= 1) mx = fmaxf(mx, __shfl_xor(mx, o));
    return mx; }
__device__ __forceinline__ void quant_store8(const u32x4 (&w)[8], float inv, signed char* dst, int lane) { u32x2* qp = (u32x2*)dst + lane;
#pragma unroll
    for (int j = 0; j < 8; ++j) { const unsigned ww[4] = {w[j].x, w[j].y, w[j].z, w[j].w}; unsigned o2[2];
#pragma unroll
        for (int h2 = 0; h2 < 2; ++h2) { const int q0 = (int)rintf(bflo(ww[2 * h2]) * inv), q1 = (int)rintf(bfhi(ww[2 * h2]) * inv), q2 = (int)rintf(bflo(ww[2 * h2 + 1]) * inv), q3 = (int)rintf(bfhi(ww[2 * h2 + 1]) * inv);
            o2[h2] = (unsigned)(q0 & 255) | ((unsigned)(q1 & 255) << 8) | ((unsigned)(q2 & 255) << 16) | ((unsigned)(q3 & 255) << 24); }
        u32x2 o; o.x = o2[0]; o.y = o2[1]; qp[64 * j] = o; } }
__device__ __forceinline__ void quant_rows2(const bf16_t* s0, const bf16_t* s1, signed char* d0, signed char* d1, int lane, float& step0, float& step1) {
    const u32x4* p0 = (const u32x4*)s0 + lane; const u32x4* p1 = (const u32x4*)s1 + lane; u32x4 w0[8], w1[8];
#pragma unroll
    for (int j = 0; j < 8; ++j) { w0[j] = p0[64 * j]; w1[j] = p1[64 * j]; }
    step0 = fmaxf(absmax8(w0), 1e-30f) * (1.0f / 127.0f); step1 = fmaxf(absmax8(w1), 1e-30f) * (1.0f / 127.0f);
    quant_store8(w0, 1.0f / step0, d0, lane); quant_store8(w1, 1.0f / step1, d1, lane);
}
__device__ __forceinline__ void rot_load(u32x4 (&w)[8], const bf16_t* src, int tl) {
#pragma unroll
    for (int j = 0; j < 8; ++j) w[j] = __builtin_nontemporal_load((const u32x4*)src + j * 256 + tl);
}
template <bool CENTER>
__device__ __forceinline__ void rot_finish(const u32x4 (&w)[8], signed char* dst, LAS float* red, int tl, int half, int wv4, int lane, float& step_out, float& sum_out) {
    f32x2 pr[32];
#pragma unroll
    for (int j = 0; j < 8; ++j) { pr[4 * j] = (f32x2){bflo(w[j].x), bfhi(w[j].x)}; pr[4 * j + 1] = (f32x2){bflo(w[j].y), bfhi(w[j].y)}; pr[4 * j + 2] = (f32x2){bflo(w[j].z), bfhi(w[j].z)}; pr[4 * j + 3] = (f32x2){bflo(w[j].w), bfhi(w[j].w)}; }
#pragma unroll
    for (int i = 0; i < 32; ++i) { const float a = pr[i][0], b = pr[i][1]; pr[i] = (f32x2){a + b, a - b}; }
#pragma unroll
    for (int h = 1; h < 32; h <<= 1)
#pragma unroll
        for (int i = 0; i < 32; ++i) if (!(i & h)) { const f32x2 a = pr[i], b = pr[i + h]; pr[i] = a + b; pr[i + h] = a - b; }
    float sm = pr[0][0];
#pragma unroll
    for (int o = 1; o < 64; o <<= 1) sm += __shfl_xor(sm, o);
    float mx = 0.f;
    if (CENTER) {
        if (lane == 0) red[half * 4 + wv4] = sm;
        __syncthreads();
        sm = (red[half * 4] + red[half * 4 + 1]) + (red[half * 4 + 2] + red[half * 4 + 3]);
        pr[0][0] -= sm * (64.0f / DFF);
    }
#pragma unroll
    for (int i = 0; i < 32; ++i) mx = fmaxf(mx, fmaxf(fabsf(pr[i][0]), fabsf(pr[i][1])));
#pragma unroll
    for (int o = 1; o < 64; o <<= 1) mx = fmaxf(mx, __shfl_xor(mx, o));
    if (lane == 0) { red[16 + half * 4 + wv4] = mx; if (!CENTER) red[half * 4 + wv4] = sm; }
    __syncthreads();
    mx = fmaxf(fmaxf(red[16 + half * 4], red[16 + half * 4 + 1]), fmaxf(red[16 + half * 4 + 2], red[16 + half * 4 + 3]));
    if (!CENTER) sm = (red[half * 4] + red[half * 4 + 1]) + (red[half * 4 + 2] + red[half * 4 + 3]);
    const float step = fmaxf(mx, 1e-30f) * (1.0f / 127.0f), inv = 1.0f / step;
#pragma unroll
    for (int jj = 0; jj < 4; ++jj) { unsigned o4[4];
#pragma unroll
        for (int d = 0; d < 4; ++d) { const f32x2 a = pr[8 * jj + 2 * d] * inv, b = pr[8 * jj + 2 * d + 1] * inv;
            const int q0 = (int)rintf(a[0]), q1 = (int)rintf(a[1]), q2 = (int)rintf(b[0]), q3 = (int)rintf(b[1]);
            o4[d] = (unsigned)(q0 & 255) | ((unsigned)(q1 & 255) << 8) | ((unsigned)(q2 & 255) << 16) | ((unsigned)(q3 & 255) << 24); }
        u32x4 o; o.x = o4[0]; o.y = o4[1]; o.z = o4[2]; o.w = o4[3]; *((u32x4*)dst + jj * 256 + tl) = o; }
    step_out = step; sum_out = sm;
    __syncthreads();
}
template <bool CENTER, class Fin>
__device__ __forceinline__ void rot_rows(const bf16_t* src, size_t src_ld, signed char* dst, int row0, int n, LAS float* red, int tl, int half, int wv4, int lane, Fin fin) {
    u32x4 wa[8], wb[8]; float st, sm;
    rot_load(wa, src + (size_t)(row0 + half) * src_ld, tl);
    for (int it = 0; it < n; it += 2) {
        const int ra = row0 + 2 * it + half, rb = ra + 2;
        rot_load(wb, src + (size_t)rb * src_ld, tl);
        rot_finish<CENTER>(wa, dst + (size_t)ra * RQ_LD, red, tl, half, wv4, lane, st, sm); if (tl == 0) fin(ra, st, sm);
        if (it + 2 < n) rot_load(wa, src + (size_t)(rb + 2) * src_ld, tl);
        rot_finish<CENTER>(wb, dst + (size_t)rb * RQ_LD, red, tl, half, wv4, lane, st, sm); if (tl == 0) fin(rb, st, sm);
    }
}
struct Args { const float* in[18]; float* out; unsigned char* ws; int ph_lo, ph_hi; };
__global__ void __launch_bounds__(NWAVES * 64, 2) fwd(Args args) {
    extern __shared__ __attribute__((aligned(16))) unsigned char lds[];
    Frame F;
    F.lds = (LAS unsigned char*)lds; F.ldsg = (char*)lds;
    F.tid = threadIdx.x; F.lane = F.tid & 63; F.wave = __builtin_amdgcn_readfirstlane(F.tid >> 6);
    F.G = gridDim.x; { const int bx = blockIdx.x; F.vcu = (F.G % 8 == 0) ? (bx % 8) * (F.G / 8) + bx / 8 : bx; }
    F.ws = args.ws; F.out = args.out;
    unsigned char* ws = args.ws;
    volatile LAS unsigned* MISC = (volatile LAS unsigned*)(F.lds + MISC_OFF);
    for (int u = F.tid; u < (LDS_BYTES - LDSCTL_OFF) / 4; u += NWAVES * 64) ((LAS unsigned*)(F.lds + LDSCTL_OFF))[u] = 0u;
    __syncthreads();
    XcdBarrier bar; bar.bar = (unsigned*)(ws + WS_CTL) + CW_BAR; bar.x = 0; bar.st = nullptr;
    if (MK_ONE_LAUNCH) bar = xcd_barrier_post((unsigned*)(ws + WS_CTL) + CW_BAR, MISC + 8);
    const int lo = args.ph_lo, hi = args.ph_hi;
#ifndef PH_MASK
#define PH_MASK 0xFFFF
#endif
#define IN(k) (((PH_MASK >> (k)) & 1) && lo <= (k) && (k) < hi)
#define SEAM(k) do { if (IN(k) && IN((k) + 1)) xcd_barrier(bar); } while (0)

#define ARGP(k) (((const float* const volatile*)((const Args*)__builtin_amdgcn_kernarg_segment_ptr())->in)[k])
#define in_x ARGP(0)
#define in_mem ARGP(1)
#define g_mix ARGP(2)
#define w_in ARGP(3)
#define w_gate_up ARGP(4)
#define b_gate ARGP(5)
#define gla_norm_g ARGP(6)
#define w_out ARGP(7)
#define g_cross ARGP(8)
#define g_mem ARGP(9)
#define w_cq ARGP(10)
#define w_ck ARGP(11)
#define w_cv ARGP(12)
#define w_co ARGP(13)
#define g_mlp ARGP(14)
#define w_up ARGP(15)
#define w_down ARGP(16)
#define g_final ARGP(17)
    float* rstd_x = (float*)(ws + WS_RSTDX); float* colq = (float*)(ws + WS_RSTD1); float* rowq = (float*)(ws + WS_RSTD2);
    signed char* W_upq = (signed char*)F.out + 128 * MiB; signed char* hq = (signed char*)F.out + 192 * MiB;
    float* colq_up = (float*)(ws + WS_WGLOW + 262144); float* rowq2 = (float*)(ws + WS_WGLOW + 393216);
    signed char* uq = (signed char*)(ws + WS_UQ); signed char* Wdq = (signed char*)(ws + WS_WDQ);
    float* sw_dn = (float*)(ws + WS_WGLOW + 524288); float* cw_dn = sw_dn + 4096; float* sa_u = cw_dn + 4096; float* m_u = sa_u + T;
    signed char* xq = (signed char*)(ws + WS_OMIX); signed char* W_inq = (signed char*)(ws + WS_OMIX + 64 * MiB);
    float* ropec = (float*)(ws + WS_ROPEC); float* ropes = (float*)(ws + WS_ROPES); float* kmean = (float*)(ws + WS_KMEAN);
    float* glow = (float*)(ws + WS_GLOW); float* part = (float*)(ws + WS_PART);
    bf16_t* W_inT = (bf16_t*)(ws + WS_WIN); bf16_t* W_outT = (bf16_t*)(ws + WS_WOUT); bf16_t* W_ckvT = (bf16_t*)(ws + WS_WCKV); bf16_t* W_cqb = (bf16_t*)(ws + WS_WCQ);
    bf16_t* W_coT = (bf16_t*)(ws + WS_WCO); bf16_t* W_upT = (bf16_t*)(ws + WS_WUP); bf16_t* W_dnT = (bf16_t*)(ws + WS_WDN);
    bf16_t* WqkT = (bf16_t*)(ws + WS_WQK); bf16_t* WvoT = (bf16_t*)(ws + WS_WVO); bf16_t* kcvc = (bf16_t*)(ws + WS_KCVC); bf16_t* memn = (bf16_t*)(ws + WS_MEMN);
    bf16_t* hb = (bf16_t*)(ws + WS_HB); bf16_t* proj = (bf16_t*)(ws + WS_PROJ); bf16_t* qkvh = (bf16_t*)(ws + WS_QKVH); bf16_t* omix = (bf16_t*)(ws + WS_OMIX); bf16_t* Pm = (bf16_t*)(ws + WS_P); bf16_t* Ub = (bf16_t*)(ws + WS_U);
    bf16_t* dSt = (bf16_t*)F.out;
    float* decay = (float*)(ws + WS_DECAY); bf16_t* W_glowT = (bf16_t*)(ws + WS_WGLOW);
    const int gw = F.vcu * NWAVES + F.wave, NGW = F.G * NWAVES;

    constexpr int NQB = (IN_N - IN_Q0) / 64;
    static_assert(NQB <= 200, "P0 needs some workgroups without an int8 in-projection block");
    if (IN(0)) {
        LAS float* scr = (LAS float*)(F.lds + F.wave * 17408);
        const int bx = (int)blockIdx.x;
        if (bx < NQB) {
            const int nb = IN_Q0 / 64 + bx, src0 = (nb * 64 >= 4096) ? 16 : 0;
            { const float* wsrc = w_in; const float* gsrc = g_mix; const int wv = F.wave;
              p0_pipe(8, [&](int i) { return p0_item(wsrc, INW, DM, gsrc, W_inT, IN_N / 64, src0, 0, (wv + 8 * i) * (IN_N / 64) + nb); }, scr, F.lane); }
            VM_WAIT(); __syncthreads();
            for (int p = 0; p < 4; ++p) { const int n = 64 * bx + 8 * F.wave + 2 * p; float s0, s1;
                quant_rows2(W_inT + (size_t)(IN_Q0 + n) * DM, W_inT + (size_t)(IN_Q0 + n + 1) * DM, W_inq + (size_t)n * DM, W_inq + (size_t)(n + 1) * DM, F.lane, s0, s1);
                if (F.lane == 0) { colq[n] = s0; colq[n + 1] = s1; } }
        } else {
            constexpr int I_INL = (DM / 64) * (IN_Q0 / 64);
            for (int it = (bx - NQB) * NWAVES + F.wave; it < I_INL; it += (256 - NQB) * NWAVES) { const int kb = it / (IN_Q0 / 64), nb = it % (IN_Q0 / 64);
                p0_transpose64(w_in, INW, DM, g_mix, W_inT, IN_N / 64, (nb * 64 >= 4096) ? 16 : 0, 0, scr, kb * (IN_N / 64) + nb, F.lane); }
        }
        { int m, mstep, mcnt;
          if (bx < NQB) { m = bx * 48 + F.wave * 6; mstep = 1; mcnt = 6; } else { m = NQB * 48 + (bx - NQB) * NWAVES + F.wave; mstep = (256 - NQB) * NWAVES; mcnt = T; }
          for (int j = 0; j < mcnt && m < T; ++j, m += mstep) {
            const f32x4* xr = (const f32x4*)(in_x + (size_t)m * DM) + F.lane; f32x4 v[16]; float s2 = 0.f;
#pragma unroll
            for (int j2 = 0; j2 < 16; ++j2) { v[j2] = __builtin_nontemporal_load(xr + 64 * j2); s2 += (v[j2][0] * v[j2][0] + v[j2][1] * v[j2][1]) + (v[j2][2] * v[j2][2] + v[j2][3] * v[j2][3]); }
            const float rs = 1.0f / sqrtf(wave_sum(s2) * (1.0f / DM) + EPS);
            float mx = 0.f;
#pragma unroll
            for (int j2 = 0; j2 < 16; ++j2) mx = fmaxf(fmaxf(mx, fmaxf(fabsf(v[j2][0]), fabsf(v[j2][1]))), fmaxf(fabsf(v[j2][2]), fabsf(v[j2][3])));
#pragma unroll
            for (int o = 1; o < 64; o <<= 1) mx = fmaxf(mx, __shfl_xor(mx, o));
            const float step = fmaxf(mx, 1e-30f) * (1.0f / 127.0f), inv = 1.0f / step;
            if (F.lane == 0) { rstd_x[m] = rs; rowq[m] = rs * step; }
            u32x2* o8 = (u32x2*)(hb + (size_t)m * DM) + F.lane; unsigned* q4 = (unsigned*)(xq + (size_t)m * DM) + F.lane;
#pragma unroll
            for (int j2 = 0; j2 < 16; ++j2) { u32x2 w; w.x = cvt_pk_bf16(v[j2][0], v[j2][1]); w.y = cvt_pk_bf16(v[j2][2], v[j2][3]); o8[64 * j2] = w;
                const int q0 = (int)rintf(v[j2][0] * inv), q1 = (int)rintf(v[j2][1] * inv), q2 = (int)rintf(v[j2][2] * inv), q3 = (int)rintf(v[j2][3] * inv);
                q4[64 * j2] = (unsigned)(q0 & 255) | ((unsigned)(q1 & 255) << 8) | ((unsigned)(q2 & 255) << 16) | ((unsigned)(q3 & 255) << 24); }
          } }
        for (int m = gw; m < TM; m += NGW) {
            const f32x4* xr = (const f32x4*)(in_mem + (size_t)m * DM) + F.lane; f32x4 v[16]; float s2 = 0.f;
#pragma unroll
            for (int j = 0; j < 16; ++j) { v[j] = xr[64 * j]; s2 += (v[j][0] * v[j][0] + v[j][1] * v[j][1]) + (v[j][2] * v[j][2] + v[j][3] * v[j][3]); }
            const float rs = 1.0f / sqrtf(wave_sum(s2) * (1.0f / DM) + EPS);
            u32x2* o8 = (u32x2*)(memn + (size_t)m * DM) + F.lane;
#pragma unroll
            for (int j = 0; j < 16; ++j) { const f32x4 g = *((const f32x4*)g_mem + F.lane + 64 * j); u32x2 w; w.x = cvt_pk_bf16(v[j][0] * rs * g[0], v[j][1] * rs * g[1]); w.y = cvt_pk_bf16(v[j][2] * rs * g[2], v[j][3] * rs * g[3]); o8[64 * j] = w; }
        }
        for (int e = gw * 64 + F.lane; e < SEQ * 16; e += NGW * 64) { const int pos = e >> 4, i = e & 15;
            const float inv_freq = powf(500000.0f, -(float)i * (1.0f / 16.0f)); const float ang = (float)pos * inv_freq;
            ropec[e] = cosf(ang); ropes[e] = sinf(ang);
            const int n = e >> 12, kk = e & 4095; W_glowT[e] = gla::f2bf1(w_in[(size_t)kk * INW + 4096 + n] * g_mix[kk]); }
    }
    SEAM(0);

    if (IN(2)) {
        const int slot = ((int)blockIdx.x & 63) % 3;
#define P2_SLICE() do {                                                                                                                                                             \
        int ln_ = F.lane, wv_ = F.wave, bx_ = (int)blockIdx.x; asm volatile("" : "+v"(ln_)); asm volatile("" : "+s"(wv_)); asm volatile("" : "+s"(bx_));     \
        const int ln = ln_, wv = wv_, bx = bx_; LAS float* scr = (LAS float*)(F.lds + wv * 17408);                                                                                      \
                                                                                           \
        { const float* wsrc = w_up; const float* gsrc = g_mlp;                                                                                               \
          p0_pipe(8, [&](int i) { return p0_item(wsrc, DFF, DM, gsrc, W_upT, DFF / 64, 0, 0, (wv + 8 * i) * (DFF / 64) + bx); }, scr, ln); }                                     \
        VM_WAIT(); __syncthreads();                                                                                                                                                 \
        for (int p = 0; p < 4; ++p) { const int n = 64 * bx + 8 * wv + 2 * p; float s0, s1;                                                                                     \
            quant_rows2(W_upT + (size_t)n * DM, W_upT + (size_t)(n + 1) * DM, W_upq + (size_t)n * DM, W_upq + (size_t)(n + 1) * DM, ln, s0, s1);                                \
            if (ln == 0) { colq_up[n] = s0; colq_up[n + 1] = s1; } }                                                                                                            \
                                         \
        { constexpr int I_SQ = (DM / 64) * (DM / 64), I_DN = (DFF / 64) * (DM / 64); static_assert(4 * I_SQ + I_DN == 256 * 128, "generic weight items");                            \
          const float* s_out = w_out; const float* s_ck = w_ck; const float* s_cv = w_cv; const float* s_co = w_co; const float* s_dn = w_down; const int it0 = bx * 128 + wv;   \
          p0_pipe(16, [&](int i) { int r = it0 + 8 * i;                                                                                                                             \
              if (r < I_SQ) return p0_item(s_out, DM, DM, nullptr, W_outT, DM / 64, 0, 0, r); r -= I_SQ;                                                                            \
              if (r < I_SQ) return p0_item(s_ck, DM, DM, nullptr, W_ckvT, DM / 64, 0, 0, r); r -= I_SQ;                                                                             \
              if (r < I_SQ) return p0_item(s_cv, DM, DM, nullptr, W_ckvT, DM / 64, 0, DM, r); r -= I_SQ;                                                                            \
              if (r < I_SQ) return p0_item(s_co, DM, DM, nullptr, W_coT, DM / 64, 0, 0, r); r -= I_SQ;                                                                              \
              return p0_item(s_dn, DM, DFF, nullptr, W_dnT, DM / 64, 0, 0, r); }, scr, ln);                                                                                     \
          for (int q = 0; q < 2; ++q) {                                                                                      \
              const int kk = bx * 16 + wv * 2 + q; const float g = g_cross[kk]; const f32x4* src = (const f32x4*)(w_cq + (size_t)kk * DM) + ln; u32x2* dst = (u32x2*)(W_cqb + (size_t)kk * DM) + ln;   \
              _Pragma("unroll") for (int j = 0; j < 16; ++j) { const f32x4 v = __builtin_nontemporal_load(src + 64 * j); u32x2 w; w.x = cvt_pk_bf16(v[0] * g, v[1] * g); w.y = cvt_pk_bf16(v[2] * g, v[3] * g); dst[64 * j] = w; } } }   \
                                                               \
        { const int it = F.vcu * NWAVES + wv, grp = it >> 1, kh = it & 1, i = ln & 15, kq = ln >> 4;                                                                    \
            const bf16_t* ap = hb + (size_t)(grp * 16 + i) * DM + kh * 2048 + kq * 8; const bf16_t* bp = W_glowT + (size_t)i * DM + kh * 2048 + kq * 8;                             \
            f32x4 acc = {0.f, 0.f, 0.f, 0.f};                                                                                                                                       \
            _Pragma("unroll 8") for (int k0 = 0; k0 < 2048; k0 += 32) acc = mfma16_h(*(const bf16x8*)(ap + k0), *(const bf16x8*)(bp + k0), acc);   \
            __syncthreads();                                                                                                                                                        \
            LAS f32x4* xch = (LAS f32x4*)F.lds + (wv >> 1) * 64 + ln;                                                                                                       \
            if (kh == 1) *xch = acc;                                                                                                                                                \
            __syncthreads();                                                                                                                                                        \
            if (kh == 0) { acc = acc + *xch;                                                                                                                                        \
                _Pragma("unroll") for (int r = 0; r < 4; ++r) { const int row = grp * 16 + 4 * kq + r; glow[(size_t)row * 16 + i] = acc[r] * rstd_x[row]; } } }                     \
        VM_WAIT(); __syncthreads(); } while (0)
        if (slot == 0) P2_SLICE();
        { pg8::StdPtrs P{(const char*)hb, (const char*)W_inT, DM, DM, DM, 0, 0}; pg8::StaticOrder S; S.init(T, IN_Q0, F.G, (int)blockIdx.x);
          pg8::EpiBf16<0> E{proj, PROJ_LD, rstd_x};
          pg8::gemm_phase<pg8::EpiBf16<0>, pg8::StaticOrder, pg8::StdPtrs, true>(F.lds, P, S, E); }
        if (slot == 1) P2_SLICE();
        { pg8::StdPtrs P{(const char*)xq, (const char*)W_inq, DM / 2, DM / 2, DM / 2, 0, 0}; pg8::StaticOrder S; S.init(T, IN_N - IN_Q0, F.G, (int)blockIdx.x);
          pg8::EpiProjMoba E{proj, qkvh, rowq, colq, ropec, ropes, IN_Q0 / 256};
          pg8::gemm_phase<pg8::EpiProjMoba, pg8::StaticOrder, pg8::StdPtrs, true, true>(F.lds, P, S, E); }
        if (slot == 2) P2_SLICE();
#undef P2_SLICE
    }
    SEAM(2);

    if (IN(3)) {
        for (int it = gw; it < 64 * 16; it += NGW) {
            const int bh = it >> 4, blk = it & 15, b = bh >> 4, h = bh & 15, rsub = F.lane >> 4, c8 = (F.lane & 15) * 8;
            const bf16_t* kp = qkvh + QKVH_T + ((size_t)bh * SEQ + blk * 256 + rsub) * 128 + c8; float a[8];
#pragma unroll
            for (int j = 0; j < 8; ++j) a[j] = 0.f;
#pragma unroll 16
            for (int r = 0; r < 64; ++r) { const u32x4 w = *(const u32x4*)(kp + (size_t)(4 * r) * 128);
                a[0] += bflo(w.x); a[1] += bfhi(w.x); a[2] += bflo(w.y); a[3] += bfhi(w.y); a[4] += bflo(w.z); a[5] += bfhi(w.z); a[6] += bflo(w.w); a[7] += bfhi(w.w); }
#pragma unroll
            for (int j = 0; j < 8; ++j) { a[j] += __shfl_xor(a[j], 16); a[j] += __shfl_xor(a[j], 32); a[j] *= (1.0f / 256.0f); }
            if (rsub == 0) { float* o = kmean + (size_t)it * 128 + c8; *(f32x4*)o = (f32x4){a[0], a[1], a[2], a[3]}; *(f32x4*)(o + 4) = (f32x4){a[4], a[5], a[6], a[7]}; }
        }
        VM_WAIT(); __syncthreads();
        { pg8::StdPtrs P{(const char*)memn, (const char*)W_ckvT, DM, DM, DM, 0, 0}; pg8::StaticOrder S; S.init(TM, 2 * DM, F.G, (int)blockIdx.x);
          pg8::EpiBf16<0> E{kcvc, 2 * DM, nullptr};
          pg8::gemm_phase<pg8::EpiBf16<0>, pg8::StaticOrder, pg8::StdPtrs, true>(F.lds, P, S, E); }
        { const int bx = (int)blockIdx.x; int u0, nu;
          if (bx < 128) { u0 = bx * 4; nu = 4; } else { u0 = 512 + (bx - 128) * 12; nu = 12; }
          for (int j = 0; j < nu; ++j) gla::ga_unit(F.lds, u0 + j, proj, glow, w_gate_up, b_gate, dSt, decay, F.tid, F.wave, F.lane); }
    }
    SEAM(3);

    if (IN(4)) {
        for (int e = (F.vcu * NWAVES * 64) + F.tid; e < 32 * 256 * 16; e += F.G * NWAVES * 64) {
            const int bh = e >> 12, rem = e & 4095, v = rem >> 4, kg = rem & 15;
            u32x4* p = (u32x4*)(dSt + ((size_t)(bh * 64) * 256 + v) * 128 + kg * 8);
            const f32x4* dp = (const f32x4*)(decay + (size_t)bh * 64 * 128 + kg * 8);
            float st[8];
#pragma unroll
            for (int j = 0; j < 8; ++j) st[j] = 0.f;
#pragma unroll 8
            for (int n = 0; n < 64; ++n) { const u32x4 w = p[(size_t)n * 4096]; const f32x4 d0 = dp[n * 32], d1 = dp[n * 32 + 1];
                u32x4 o; o.x = cvt_pk_bf16(st[0], st[1]); o.y = cvt_pk_bf16(st[2], st[3]); o.z = cvt_pk_bf16(st[4], st[5]); o.w = cvt_pk_bf16(st[6], st[7]); p[(size_t)n * 4096] = o;
                st[0] = st[0] * d0[0] + bflo(w.x); st[1] = st[1] * d0[1] + bfhi(w.x); st[2] = st[2] * d0[2] + bflo(w.y); st[3] = st[3] * d0[3] + bfhi(w.y);
                st[4] = st[4] * d1[0] + bflo(w.z); st[5] = st[5] * d1[1] + bfhi(w.z); st[6] = st[6] * d1[2] + bflo(w.w); st[7] = st[7] * d1[3] + bfhi(w.w); }
        }
        __syncthreads();
        { pg8::QkVoPtrs P{(const char*)kcvc, (const char*)W_cqb, (const char*)W_coT, 1024, 0, 0};
          pg8::QkVoPtrs Pq = P; Pq.lda = 2 * DM; Pq.ldb = DM; pg8::LinearOrder Sq{256, F.G, F.vcu, 0};
          pg8::EpiQkVo E{WqkT, WvoT};
          pg8::gemm_phase<pg8::EpiQkVo, pg8::LinearOrder, pg8::QkVoPtrs, true>(F.lds, Pq, Sq, E);
          pg8::QkVoPtrs Pv = P; Pv.lda = DM; Pv.ldb = 2 * DM;
          pg8::LinearOrder Sv{256, F.G, F.vcu, 256};
          pg8::gemm_phase<pg8::EpiQkVo, pg8::LinearOrder, pg8::QkVoPtrs, true>(F.lds, Pv, Sv, E); }
        {
            char* al = F.ldsg;
            const int total = 64 * 8;
            int L = F.vcu;
            if (L < total) {
                int pass = 0; mb::BlockRef cur = moba_ref(qkvh, omix, kmean, L, 0); mb::Seam S;
                mb::moba_prime(cur, al, S);
                for (;;) {
                    const bool more_pass = pass == 0, more_item = L + F.G < total, last = !more_pass && !more_item;
                    int passn = pass + 1, Ln = L; if (!more_pass) { passn = 0; Ln = more_item ? L + F.G : L; }
                    const mb::BlockRef nxt = last ? cur : moba_ref(qkvh, omix, kmean, Ln, passn);
                    mb::moba_block(cur, nxt, al, S);
                    if (last) break;
                    cur = nxt; pass = passn; L = Ln;
                }
            }
            VM_WAIT(); __syncthreads();
        }
    }
    SEAM(4);

    if (IN(5)) {
        for (int un = F.vcu; un < 2048; un += F.G) gla::gc_unit(F.lds, un, proj, dSt, gla_norm_g, omix, F.tid, F.wave, F.lane);
    }
    SEAM(5);

    if (IN(6)) {
        pg8::StdPtrs P{(const char*)omix, (const char*)W_outT, DM, DM, DM, 0, 0}; pg8::StaticOrder S; S.init(T, DM, F.G, (int)blockIdx.x);
        pg8::EpiResid<false> E{(const void*)hb, hb, part};
        pg8::gemm_phase<pg8::EpiResid<false>, pg8::StaticOrder, pg8::StdPtrs, true>(F.lds, P, S, E);
    }
    SEAM(6);
    if (IN(7)) {
        pg8::StdPtrs P{(const char*)hb, (const char*)WqkT, DM, DM, DM, 16, (size_t)1024 * DM * 2}; pg8::StaticOrder S; S.init(T, 1024, F.G, (int)blockIdx.x);
        pg8::EpiSoftmax E{Pm, part};
        pg8::gemm_phase<pg8::EpiSoftmax, pg8::StaticOrder, pg8::StdPtrs, false>(F.lds, P, S, E);
    }
    SEAM(7);
    if (IN(8)) {
        pg8::StdPtrs P{(const char*)Pm, (const char*)WvoT, 1024, 1024, 1024, 16, (size_t)DM * 1024 * 2}; pg8::StaticOrder S; S.init(T, DM, F.G, (int)blockIdx.x);
        pg8::EpiResid<false> E{(const void*)hb, hb, part};
        pg8::gemm_phase<pg8::EpiResid<false>, pg8::StaticOrder, pg8::StdPtrs, true>(F.lds, P, S, E);
    }
    SEAM(8);
    if (IN(9)) {
        for (int row = gw; row < T; row += 2 * NGW) { const int row2 = row + NGW;
            const float pa = part[(size_t)row * 64 + F.lane], pb = part[(size_t)row2 * 64 + F.lane];
            float st0, st1; quant_rows2(hb + (size_t)row * DM, hb + (size_t)row2 * DM, hq + (size_t)row * DM, hq + (size_t)row2 * DM, F.lane, st0, st1);
            const float rsa = 1.0f / sqrtf(wave_sum(pa) * (1.0f / DM) + EPS), rsb = 1.0f / sqrtf(wave_sum(pb) * (1.0f / DM) + EPS);
            if (F.lane == 0) { rowq2[row] = rsa * st0; rowq2[row2] = rsb * st1; }
        }
        { LAS float* red = (LAS float*)F.lds; const int half = F.wave >> 2, wv4 = F.wave & 3, tl = F.tid & 255;
          rot_rows<false>(W_dnT, (size_t)DFF, Wdq, (int)blockIdx.x * 16, 8, red, tl, half, wv4, F.lane, [&](int n, float st, float sm) { sw_dn[n] = st * (1.0f / 64.0f); cw_dn[n] = sm; }); }
    }
    SEAM(9);
    if (IN(10)) {
        pg8::StdPtrs P{(const char*)hq, (const char*)W_upq, DM / 2, DM / 2, DM / 2, 0, 0}; pg8::StaticOrder S; S.init(T, DFF, F.G, (int)blockIdx.x);
        pg8::EpiUpI8 E{Ub, U_LD, rowq2, colq_up};
        pg8::gemm_phase<pg8::EpiUpI8, pg8::StaticOrder, pg8::StdPtrs, true, true>(F.lds, P, S, E);
    }
    SEAM(10);
    if (IN(11)) {
        LAS float* red = (LAS float*)F.lds; const int half = F.wave >> 2, wv4 = F.wave & 3, tl = F.tid & 255;
        rot_rows<true>(Ub, (size_t)U_LD, uq, (int)blockIdx.x * 64, 32, red, tl, half, wv4, F.lane, [&](int row, float st, float sm) { sa_u[row] = st; m_u[row] = sm * (1.0f / DFF); });
    }
    SEAM(11);
    if (IN(12)) {
        pg8::StdPtrs P{(const char*)uq, (const char*)Wdq, DFF / 2, RQ_LD / 2, RQ_LD / 2, 0, 0}; pg8::StaticOrder S; S.init(T, DM, F.G, (int)blockIdx.x);
        pg8::EpiResidI8 E{hb, hb, part, sa_u, m_u, sw_dn, cw_dn};
        pg8::gemm_phase<pg8::EpiResidI8, pg8::StaticOrder, pg8::StdPtrs, true, true>(F.lds, P, S, E);
    }
    SEAM(12);
    if (IN(13)) {
        const f32x4* gfp = (const f32x4*)g_final + 2 * F.lane;
        for (int row = gw; row < T; row += 2 * NGW) {
            const int row2 = row + NGW;
            const float pa = part[(size_t)row * 64 + F.lane], pb = part[(size_t)row2 * 64 + F.lane];
            const u32x4* hp = (const u32x4*)(hb + (size_t)row * DM) + F.lane; const u32x4* hq = (const u32x4*)(hb + (size_t)row2 * DM) + F.lane; u32x4 wa[8], wb[8];
#pragma unroll
            for (int j = 0; j < 8; ++j) { wa[j] = hp[64 * j]; wb[j] = hq[64 * j]; }
            const float rsa = 1.0f / sqrtf(wave_sum(pa) * (1.0f / DM) + EPS), rsb = 1.0f / sqrtf(wave_sum(pb) * (1.0f / DM) + EPS);
            f32x4* oa = (f32x4*)(F.out + (size_t)row * DM) + 2 * F.lane; f32x4* ob = (f32x4*)(F.out + (size_t)row2 * DM) + 2 * F.lane;
#pragma unroll
            for (int j = 0; j < 8; ++j) { const f32x4 g0 = gfp[128 * j], g1 = gfp[128 * j + 1]; const u32x4 w = wa[j], w2 = wb[j];
                const f32x4 v0 = {bflo(w.x) * g0[0] * rsa, bfhi(w.x) * g0[1] * rsa, bflo(w.y) * g0[2] * rsa, bfhi(w.y) * g0[3] * rsa}, v1 = {bflo(w.z) * g1[0] * rsa, bfhi(w.z) * g1[1] * rsa, bflo(w.w) * g1[2] * rsa, bfhi(w.w) * g1[3] * rsa};
                const f32x4 u0 = {bflo(w2.x) * g0[0] * rsb, bfhi(w2.x) * g0[1] * rsb, bflo(w2.y) * g0[2] * rsb, bfhi(w2.y) * g0[3] * rsb}, u1 = {bflo(w2.z) * g1[0] * rsb, bfhi(w2.z) * g1[1] * rsb, bflo(w2.w) * g1[2] * rsb, bfhi(w2.w) * g1[3] * rsb};
                __builtin_nontemporal_store(v0, oa + 128 * j); __builtin_nontemporal_store(v1, oa + 128 * j + 1); __builtin_nontemporal_store(u0, ob + 128 * j); __builtin_nontemporal_store(u1, ob + 128 * j + 1); } }
    }
#undef IN
#undef SEAM
}

extern "C" void kernel_launch(void* const* d_in, const int* in_sizes, int n_in, void* d_out, int out_size, void* d_ws, size_t ws_size, hipStream_t stream) {
    static int grid = 0;
    if (grid == 0) {
        if (n_in != 18 || in_sizes[0] != T * DM || out_size != T * DM || ws_size < WS_END) { fprintf(stderr, "kernel_launch: unexpected shapes / workspace (n_in %d, ws %zu < %zu)\n", n_in, ws_size, (size_t)WS_END); grid = -1; return; }
        int dev = 0, cus = 0;
        if (hipGetDevice(&dev) != hipSuccess || hipDeviceGetAttribute(&cus, hipDeviceAttributeMultiprocessorCount, dev) != hipSuccess) { grid = -1; return; }
        if (hipFuncSetAttribute((const void*)fwd, hipFuncAttributeMaxDynamicSharedMemorySize, LDS_BYTES) != hipSuccess) { fprintf(stderr, "kernel_launch: hipFuncSetAttribute failed\n"); grid = -1; return; }
        int per_cu = 0; (void)hipOccupancyMaxActiveBlocksPerMultiprocessor(&per_cu, (const void*)fwd, NWAVES * 64, LDS_BYTES); (void)hipGetLastError();
        if (per_cu < 1) fprintf(stderr, "kernel_launch: occupancy query reports %d blocks per CU\n", per_cu);
        grid = cus;
        if (grid != 256) { fprintf(stderr, "kernel_launch: this kernel needs a 256-CU device (got %d)\n", grid); grid = -1; return; }
    }
    if (grid < 0) return;
    (void)hipMemsetAsync((char*)d_ws + WS_CTL, 0, CTL_ZERO_BYTES, stream);
    Args a{};
    for (int i = 0; i < 18; ++i) a.in[i] = (const float*)d_in[i];
    a.out = (float*)d_out; a.ws = (unsigned char*)d_ws;
#if MK_ONE_LAUNCH
    a.ph_lo = 0; a.ph_hi = NPHASE;
    hipLaunchKernelGGL(fwd, dim3(grid), dim3(NWAVES * 64), LDS_BYTES, stream, a);
#else
    for (int p = 0; p < NPHASE; ++p) { a.ph_lo = p; a.ph_hi = p + 1;
        for (int rep = 0; rep < 1 + ((PROBE_DUP >> p) & 1) * PROBE_DUP_N; ++rep) hipLaunchKernelGGL(fwd, dim3(grid), dim3(NWAVES * 64), LDS_BYTES, stream, a); }
#endif
}
```

```cpp
#include <hip/hip_runtime.h>
#include <cstdio>
#include <cstdint>

#ifndef PROBE_DUP
#define PROBE_DUP 0
#define PROBE_DUP_N 1
#endif
#ifndef MK_ONE_LAUNCH
#define MK_ONE_LAUNCH 1
#endif

constexpr int BATCH = 4, SEQ = 4096, DM = 4096, T = BATCH * SEQ;
constexpr int NMEM = 256, TM = BATCH * NMEM;
constexpr int INW = 12304, IN_N = 12288, PROJ_LD = 6144;
constexpr int C_GQ = 0, C_GK = 1024, C_GV = 2048, C_GOUT = 4096;
constexpr size_t QKVH_T = (size_t)BATCH * 16 * SEQ * 128;
constexpr int DFF = 16384, U_LD = DFF + 64;
constexpr float EPS = 1e-6f;
constexpr int RQ_LD = DFF + 128;
constexpr int IN_Q0 = 6144;

constexpr size_t MiB = 1u << 20;
constexpr size_t WS_CTL = 0, CTL_ZERO_BYTES = 32768;
constexpr size_t WS_RSTDX = 1 * MiB, WS_RSTD1 = WS_RSTDX + 65536, WS_RSTD2 = WS_RSTD1 + 65536;
constexpr size_t WS_ROPEC = 1 * MiB + 262144, WS_ROPES = WS_ROPEC + 262144, WS_KMEAN = WS_ROPES + 262144;
constexpr size_t WS_GLOW = 3 * MiB, WS_PART = 4 * MiB;
constexpr size_t WS_WIN = 8 * MiB, WS_WOUT = 104 * MiB, WS_WCKV = 136 * MiB, WS_WCQ = 200 * MiB, WS_WCO = 232 * MiB, WS_WUP = 264 * MiB, WS_WDN = 392 * MiB;
constexpr size_t WS_WQK = 520 * MiB, WS_WVO = 552 * MiB, WS_KCVC = 584 * MiB, WS_MEMN = 600 * MiB, WS_HB = 608 * MiB, WS_BIG = 736 * MiB, WS_DECAY = 1252 * MiB, WS_WGLOW = 1253 * MiB, WS_END = 1254 * MiB;
constexpr size_t WS_UQ = 8 * MiB, WS_WDQ = 268 * MiB;
constexpr size_t WS_PROJ = WS_BIG, WS_QKVH = WS_BIG + 192 * MiB, WS_OMIX = WS_BIG + 384 * MiB, WS_P = WS_BIG, WS_U = WS_BIG;

#define GAS __attribute__((address_space(1)))
#define LAS __attribute__((address_space(3)))
typedef unsigned short bf16_t;
typedef short bf16x8 __attribute__((ext_vector_type(8)));
typedef short s16x4 __attribute__((ext_vector_type(4)));
typedef float f32x2 __attribute__((ext_vector_type(2)));
typedef float f32x4 __attribute__((ext_vector_type(4)));
typedef float f32x16 __attribute__((ext_vector_type(16)));
typedef unsigned u32x2 __attribute__((ext_vector_type(2)));
typedef unsigned u32x4 __attribute__((ext_vector_type(4)));
typedef int i32x4 __attribute__((ext_vector_type(4)));

__device__ __forceinline__ unsigned cvt_pk_bf16(float lo, float hi) { unsigned r; asm volatile("v_cvt_pk_bf16_f32 %0, %1, %2" : "=v"(r) : "v"(lo), "v"(hi)); return r; }
__device__ __forceinline__ float bf2f(unsigned short b) { return __uint_as_float(((unsigned)b) << 16); }
__device__ __forceinline__ float bflo(unsigned w) { return __uint_as_float(w << 16); }
__device__ __forceinline__ float bfhi(unsigned w) { return __uint_as_float(w & 0xffff0000u); }

namespace pg8 {
constexpr int BM = 256, BK = 64, HALF = 128, HTB = HALF * BK * 2, STAGE_BYTES = 8 * HTB, NXCD = 8, WGM = 8;
__host__ __device__ __forceinline__ int lds_byte(int r, int c) { const int st = (r >> 4) * 2 + (c >> 5), rr = r & 15, cc = c & 31, ob = rr * 64 + cc * 2; return st * 1024 + (ob ^ (((ob >> 9) & 1) << 5)); }
__host__ __device__ __forceinline__ void stage_rc(int b, int& R, int& C) { const int st = b / 1024, sb = b % 1024, swz = sb ^ (((sb >> 9) & 1) << 5); R = (st >> 1) * 16 + swz / 64; C = (st & 1) * 32 + (swz % 64) / 2; }
__host__ __device__ __forceinline__ int perm32(int rho) { const int n = rho >> 4, i = rho & 15; return 8 * (i >> 2) + 4 * n + (i & 3); }
struct Unit { int pm, pn; };

struct StaticOrder {
    int nM, nN, nwg, G, c;
    __device__ void init(int M, int N, int G_, int c_) { nM = M / BM; nN = N / BM; nwg = nM * nN; G = G_; c = c_; }
    __device__ __forceinline__ bool next(int i, Unit& u) const {
        const long L = (long)i * G + c; if (L >= nwg) return false;
        int wgid = (int)L; { const int q = nwg / NXCD, r = nwg % NXCD, xcd = wgid % NXCD, off = wgid / NXCD; wgid = (xcd < r ? xcd * (q + 1) : r * (q + 1) + (xcd - r) * q) + off; }
        const int nig = WGM * nN, gid = wgid / nig, fm = gid * WGM, gsz = (nM - fm) < WGM ? (nM - fm) : WGM;
        u.pm = fm + ((wgid % nig) % gsz); u.pn = (wgid % nig) / gsz; return true;
    }
};
struct LinearOrder {
    int n, G, c, base;
    __device__ __forceinline__ bool next(int i, Unit& u) const { const int L = i * G + c; if (L >= n) return false; u.pm = base + L; u.pn = 0; return true; }
};
struct StdPtrs {
    const char* A; const char* Bt; int K, lda, ldb, pmb; size_t bstride;
    __device__ __forceinline__ const char* a(const Unit& u) const { return A + (size_t)u.pm * BM * lda * 2; }
    __device__ __forceinline__ const char* b(const Unit& u) const { return Bt + (size_t)u.pn * BM * ldb * 2 + (pmb ? (size_t)(u.pm / pmb) * bstride : 0); }
};

template <bool I8> struct AccT { typedef f32x4 type; };
template <> struct AccT<true> { typedef i32x4 type; };
template <class Epi, class Sched, class Ptrs, bool ALIGN_EPI, bool I8 = false>
__device__ __forceinline__ void gemm_phase(LAS unsigned char* lds, const Ptrs& P, const Sched& S, const Epi& E) {
    const int tid = threadIdx.x, wid = __builtin_amdgcn_readfirstlane(tid >> 6), lane = tid & 63, wr = wid >> 2, wc = wid & 3, fr = lane & 15, fq = lane >> 4;
    const int K = P.K, nt = K / BK;
    unsigned voffA[2], voffB[2];
#pragma unroll
    for (int i = 0; i < 2; ++i) { int R, C; stage_rc(tid * 16 + i * 8192, R, C); const int Rb = Epi::PERM ? ((R & ~31) + perm32(R & 31)) : R;
        voffA[i] = (unsigned)(R * P.lda + C) * 2u; voffB[i] = (unsigned)(Rb * P.ldb + C) * 2u; }
    const size_t kstep = (size_t)(BK * 2);
    const size_t hstepA = (size_t)HALF * P.lda * 2, hstepB = (size_t)HALF * P.ldb * 2;
    const unsigned ldsw = (unsigned)wid * 1024u;
    const int aoff = lds_byte(wr * 64 + fr, fq * 8), boff = lds_byte(wc * 32 + fr, fq * 8);
#define PG8_SA(b, h) (((b) * 2 + (h)) * HTB)
#define PG8_SB(b, h) ((4 + (b) * 2 + (h)) * HTB)
#define PG8_STAGE(bufoff, gbase, voff) do { _Pragma("unroll") for (int _i = 0; _i < 2; ++_i) \
        __builtin_amdgcn_global_load_lds((const unsigned*)((const char*)(gbase) + (voff)[_i]), (LAS unsigned*)(lds + (bufoff) + ldsw + _i * 8192), 16, 0, 0); } while (0)
#define PG8_LDA(dst, b, h) do { _Pragma("unroll") for (int m = 0; m < 4; ++m) _Pragma("unroll") for (int k = 0; k < 2; ++k) dst[m][k] = *(const LAS bf16x8*)(lds + PG8_SA(b, h) + aoff + m * 2048 + k * 1024); } while (0)
#define PG8_LDB(dst, b, h) do { _Pragma("unroll") for (int n = 0; n < 2; ++n) _Pragma("unroll") for (int k = 0; k < 2; ++k) dst[n][k] = *(const LAS bf16x8*)(lds + PG8_SB(b, h) + boff + n * 2048 + k * 1024); } while (0)
#define PG8_MMA(ai, bj, At, Bt) do { __builtin_amdgcn_s_setprio(1); _Pragma("unroll") for (int m = 0; m < 4; ++m) _Pragma("unroll") for (int n = 0; n < 2; ++n) _Pragma("unroll") for (int k = 0; k < 2; ++k) { \
        if constexpr (I8) acc[ai][bj][m][n] = __builtin_amdgcn_mfma_i32_16x16x64_i8(__builtin_bit_cast(i32x4, Bt[n][k]), __builtin_bit_cast(i32x4, At[m][k]), acc[ai][bj][m][n], 0, 0, 0); \
        else acc[ai][bj][m][n] = __builtin_amdgcn_mfma_f32_16x16x32_bf16(Bt[n][k], At[m][k], acc[ai][bj][m][n], 0, 0, 0); } __builtin_amdgcn_s_setprio(0); } while (0)
#define PG8_WAIT_V(n) asm volatile("s_waitcnt vmcnt(" #n ")" ::: "memory")
#define PG8_WAIT_L(n) asm volatile("s_waitcnt lgkmcnt(" #n ")" ::: "memory")
#define PG8_BAR __builtin_amdgcn_s_barrier()
#define PG8_SCHED __builtin_amdgcn_sched_barrier(0)
    Unit cur, nxt; int ui = 0;
    if (!S.next(0, cur)) return;
    typedef typename AccT<I8>::type acc_t;
    acc_t acc[2][2][4][2];
#pragma unroll
    for (int a = 0; a < 2; ++a)
#pragma unroll
        for (int b = 0; b < 2; ++b)
#pragma unroll
            for (int m = 0; m < 4; ++m)
#pragma unroll
                for (int n = 0; n < 2; ++n) acc[a][b][m][n] = acc_t{};
    bf16x8 At[4][2], B0[2][2], B1[2][2];
    const char* cA = P.a(cur); const char* cB = P.b(cur);
    PG8_STAGE(PG8_SB(0, 0), cB, voffB); PG8_STAGE(PG8_SB(0, 1), cB + hstepB, voffB); PG8_STAGE(PG8_SA(0, 0), cA, voffA); PG8_STAGE(PG8_SA(0, 1), cA + hstepA, voffA);
    if (wr == 1) PG8_BAR;
    PG8_WAIT_V(2); PG8_BAR;
    PG8_STAGE(PG8_SB(1, 0), cB + kstep, voffB); PG8_STAGE(PG8_SA(1, 0), cA + kstep, voffA); PG8_STAGE(PG8_SB(1, 1), cB + hstepB + kstep, voffB);
    PG8_WAIT_V(6); PG8_BAR;
    for (;;) {
        const bool has_next = S.next(ui + 1, nxt);
        const char* nA = has_next ? P.a(nxt) : cA; const char* nB = has_next ? P.b(nxt) : cB;
        for (int t = 0; t < nt; t += 2) {
            const bool last = (t == nt - 2);
            const char* a1 = cA + (size_t)(t + 1) * kstep;
            const char* a2 = last ? nA : cA + (size_t)(t + 2) * kstep; const char* b2 = last ? nB : cB + (size_t)(t + 2) * kstep;
            const char* a3 = a2 + kstep; const char* b3 = b2 + kstep;
            PG8_LDB(B0, 0, 0); PG8_LDB(B1, 0, 1); PG8_SCHED; PG8_LDA(At, 0, 0); PG8_STAGE(PG8_SA(1, 1), a1 + hstepA, voffA);
            PG8_WAIT_V(8); PG8_WAIT_L(0); PG8_BAR; PG8_MMA(0, 0, At, B0); PG8_MMA(0, 1, At, B1); PG8_BAR; PG8_SCHED;
            PG8_LDA(At, 0, 1); PG8_STAGE(PG8_SB(0, 0), b2, voffB); PG8_STAGE(PG8_SB(0, 1), b2 + hstepB, voffB); PG8_STAGE(PG8_SA(0, 0), a2, voffA);
            PG8_WAIT_V(8); PG8_WAIT_L(0); PG8_BAR; PG8_MMA(1, 0, At, B0); PG8_MMA(1, 1, At, B1); PG8_BAR; PG8_SCHED;
            PG8_LDB(B0, 1, 0); PG8_LDB(B1, 1, 1); PG8_SCHED; PG8_LDA(At, 1, 0); PG8_STAGE(PG8_SA(0, 1), a2 + hstepA, voffA);
            PG8_WAIT_V(8); PG8_WAIT_L(0); PG8_BAR; PG8_MMA(0, 0, At, B0); PG8_MMA(0, 1, At, B1); PG8_BAR; PG8_SCHED;
            PG8_LDA(At, 1, 1); PG8_STAGE(PG8_SB(1, 0), b3, voffB); PG8_STAGE(PG8_SB(1, 1), b3 + hstepB, voffB); PG8_STAGE(PG8_SA(1, 0), a3, voffA);
            PG8_WAIT_V(8); PG8_WAIT_L(0); PG8_BAR; PG8_MMA(1, 0, At, B0); PG8_MMA(1, 1, At, B1); PG8_BAR; PG8_SCHED;
        }
        if constexpr (ALIGN_EPI) { if (wr == 0) PG8_BAR; }
        if constexpr (!Epi::AFTER_DRAIN) { E(acc, cur, wr, wc, fr, fq); }
        if (!has_next) break;
#pragma unroll
        for (int a = 0; a < 2; ++a)
#pragma unroll
            for (int b = 0; b < 2; ++b)
#pragma unroll
                for (int m = 0; m < 4; ++m)
#pragma unroll
                    for (int n = 0; n < 2; ++n) acc[a][b][m][n] = acc_t{};
        cur = nxt; cA = nA; cB = nB; ++ui;
        if constexpr (ALIGN_EPI) { if (wr == 1) PG8_BAR; }
    }
    PG8_WAIT_V(0);
    if constexpr (!ALIGN_EPI) { if (wr == 0) PG8_BAR; }
    PG8_BAR;
    if constexpr (Epi::AFTER_DRAIN) { E.fused(acc, cur, wr, wc, fr, fq, lds, wid, lane); }
#undef PG8_SA
#undef PG8_SB
#undef PG8_STAGE
#undef PG8_LDA
#undef PG8_LDB
#undef PG8_MMA
#undef PG8_WAIT_V
#undef PG8_WAIT_L
#undef PG8_BAR
#undef PG8_SCHED
}

template <int ACT, bool RS_LDS = false> struct EpiBf16 {
    static constexpr bool PERM = true, AFTER_DRAIN = false;
    bf16_t* O; int ldc; const float* rstd;
    __device__ __forceinline__ void operator()(const f32x4 (&acc)[2][2][4][2], const Unit& u, int wr, int wc, int fr, int fq) const {
        const int row0 = u.pm * BM + wr * 64 + fr, col0 = u.pn * BM + wc * 32 + 8 * fq;
        float rsv[2][4];
#pragma unroll
        for (int ai = 0; ai < 2; ++ai)
#pragma unroll
            for (int m = 0; m < 4; ++m) rsv[ai][m] = RS_LDS ? ((const LAS float*)131072)[wr * 64 + fr + ai * HALF + m * 16] : (rstd ? rstd[row0 + ai * HALF + m * 16] : 1.f);
#pragma unroll
        for (int ai = 0; ai < 2; ++ai)
#pragma unroll
            for (int m = 0; m < 4; ++m) { const int row = row0 + ai * HALF + m * 16; const float rs = rsv[ai][m]; bf16_t* rowp = O + (size_t)row * ldc + col0;
#pragma unroll
                for (int bj = 0; bj < 2; ++bj) { f32x4 v0 = acc[ai][bj][m][0] * rs, v1 = acc[ai][bj][m][1] * rs;
                    if (ACT == 1) {
#pragma unroll
                        for (int j = 0; j < 4; ++j) { const float a = fmaxf(v0[j], 0.f), b = fmaxf(v1[j], 0.f); v0[j] = a * a; v1[j] = b * b; } }
                    u32x4 w; w.x = cvt_pk_bf16(v0[0], v0[1]); w.y = cvt_pk_bf16(v0[2], v0[3]); w.z = cvt_pk_bf16(v1[0], v1[1]); w.w = cvt_pk_bf16(v1[2], v1[3]);
                    *(u32x4*)(rowp + bj * HALF) = w; } }
    }
};
struct EpiProjMoba {
    static constexpr bool PERM = true, AFTER_DRAIN = false;
    bf16_t* O; bf16_t* QH; const float* rowq; const float* cscale; const float* ropec; const float* ropes; int pn0;
    __host__ __device__ static int qk_pos(int d) {
        if (d < 32) { const int nn = d >> 4, t = d & 15; return 32 * (t >> 2) + 4 * nn + (t & 3); }
        const int e = d - 32, wc = e / 24, r = e - 24 * wc; return 32 * wc + 8 * (1 + (r >> 3)) + (r & 7); }
    __device__ __forceinline__ void operator()(const i32x4 (&acc)[2][2][4][2], const Unit& u, int wr, int wc, int fr, int fq) const {
        const int row0 = u.pm * BM + wr * 64 + fr, col0 = u.pn * BM + wc * 32 + 8 * fq, pa = u.pn + pn0;
        f32x4 cs[2][2];
#pragma unroll
        for (int bj = 0; bj < 2; ++bj) { cs[bj][0] = *(const f32x4*)(cscale + col0 + bj * HALF); cs[bj][1] = *(const f32x4*)(cscale + col0 + bj * HALF + 4); }
        const bool hm = pa >= 24, rope = hm && (pa < 40), rl = rope && (fq == 0);
        const int t3 = (pa - 24) >> 3, hp = (pa - 24) & 7;
        float rsv[2][4]; f32x4 rcb[2], rsb[2], cd = {1.f, 1.f, 1.f, 1.f}, sd = {0.f, 0.f, 0.f, 0.f};
#pragma unroll
        for (int ai = 0; ai < 2; ++ai) { rcb[ai] = cd; rsb[ai] = sd;
#pragma unroll
            for (int m = 0; m < 4; ++m) rsv[ai][m] = rowq[row0 + ai * HALF + m * 16]; }
        if (rope) { cd = *(const f32x4*)(ropec + 16 * 16 + 4 * wc); sd = *(const f32x4*)(ropes + 16 * 16 + 4 * wc);
#pragma unroll
            for (int ai = 0; ai < 2; ++ai) { const int pos = (row0 + ai * HALF) & (SEQ - 1); rcb[ai] = *(const f32x4*)(ropec + pos * 16 + 4 * wc); rsb[ai] = *(const f32x4*)(ropes + pos * 16 + 4 * wc); } }
#pragma unroll
        for (int ai = 0; ai < 2; ++ai) { f32x4 c = rcb[ai], sn = rsb[ai];
#pragma unroll
            for (int m = 0; m < 4; ++m) { const int row = row0 + ai * HALF + m * 16; const float rs = rsv[ai][m];
                bf16_t* rowp = hm ? QH + (size_t)t3 * QKVH_T + ((size_t)((row >> 12) * 16 + 2 * hp) * SEQ + (row & (SEQ - 1))) * 128 + wc * 32 + 8 * fq : O + (size_t)row * PROJ_LD + pa * BM + wc * 32 + 8 * fq;
                const size_t bjstep = hm ? (size_t)SEQ * 128 : (size_t)HALF;
#pragma unroll
                for (int bj = 0; bj < 2; ++bj) { const i32x4 a0 = acc[ai][bj][m][0], a1 = acc[ai][bj][m][1];
                    f32x4 v0 = (f32x4){(float)a0[0], (float)a0[1], (float)a0[2], (float)a0[3]} * cs[bj][0] * rs, v1 = (f32x4){(float)a1[0], (float)a1[1], (float)a1[2], (float)a1[3]} * cs[bj][1] * rs;
                    if (rope) { const f32x4 r0 = v0 * c - v1 * sn, r1 = v0 * sn + v1 * c;
#pragma unroll
                        for (int jj = 0; jj < 4; ++jj) { v0[jj] = rl ? r0[jj] : v0[jj]; v1[jj] = rl ? r1[jj] : v1[jj]; } }
                    u32x4 w; w.x = cvt_pk_bf16(v0[0], v0[1]); w.y = cvt_pk_bf16(v0[2], v0[3]); w.z = cvt_pk_bf16(v1[0], v1[1]); w.w = cvt_pk_bf16(v1[2], v1[3]);
                    *(u32x4*)(rowp + bj * bjstep) = w; }
                if (rope) { const f32x4 c2 = c * cd - sn * sd, s2 = sn * cd + c * sd; c = c2; sn = s2; } } }
    }
};
struct EpiUpI8 {
    static constexpr bool PERM = true, AFTER_DRAIN = false;
    bf16_t* O; int ldc; const float* rowq; const float* cscale;
    __device__ __forceinline__ void operator()(const i32x4 (&acc)[2][2][4][2], const Unit& u, int wr, int wc, int fr, int fq) const {
        const int row0 = u.pm * BM + wr * 64 + fr, col0 = u.pn * BM + wc * 32 + 8 * fq;
        f32x4 cs[2][2];
#pragma unroll
        for (int bj = 0; bj < 2; ++bj) { cs[bj][0] = *(const f32x4*)(cscale + col0 + bj * HALF); cs[bj][1] = *(const f32x4*)(cscale + col0 + bj * HALF + 4); }
        float rsv[2][4];
#pragma unroll
        for (int ai = 0; ai < 2; ++ai)
#pragma unroll
            for (int m = 0; m < 4; ++m) rsv[ai][m] = rowq[row0 + ai * HALF + m * 16];
#pragma unroll
        for (int ai = 0; ai < 2; ++ai)
#pragma unroll
            for (int m = 0; m < 4; ++m) { const int row = row0 + ai * HALF + m * 16; const float rs = rsv[ai][m]; bf16_t* rowp = O + (size_t)row * ldc + col0;
#pragma unroll
                for (int bj = 0; bj < 2; ++bj) { const i32x4 a0 = acc[ai][bj][m][0], a1 = acc[ai][bj][m][1];
                    f32x4 v0 = (f32x4){(float)a0[0], (float)a0[1], (float)a0[2], (float)a0[3]} * cs[bj][0] * rs, v1 = (f32x4){(float)a1[0], (float)a1[1], (float)a1[2], (float)a1[3]} * cs[bj][1] * rs;
#pragma unroll
                    for (int j = 0; j < 4; ++j) { const float a = fmaxf(v0[j], 0.f), b = fmaxf(v1[j], 0.f); v0[j] = a * a; v1[j] = b * b; }
                    u32x4 w; w.x = cvt_pk_bf16(v0[0], v0[1]); w.y = cvt_pk_bf16(v0[2], v0[3]); w.z = cvt_pk_bf16(v1[0], v1[1]); w.w = cvt_pk_bf16(v1[2], v1[3]);
                    *(u32x4*)(rowp + bj * HALF) = w; } }
    }
};
template <bool BASE_F32> struct EpiResid {
    static constexpr bool PERM = true, AFTER_DRAIN = false;
    static_assert(!BASE_F32, "the residual base is bf16 in every phase of this kernel");
    const void* base; bf16_t* hout; float* part;
    __device__ __forceinline__ void operator()(const f32x4 (&acc)[2][2][4][2], const Unit& u, int wr, int wc, int fr, int fq) const {
        const int row0 = u.pm * BM + wr * 64 + fr, col0 = u.pn * BM + wc * 32 + 8 * fq;
#pragma unroll
        for (int ai = 0; ai < 2; ++ai) {
            u32x4 bw[4][2];
#pragma unroll
            for (int m = 0; m < 4; ++m)
#pragma unroll
                for (int bj = 0; bj < 2; ++bj) bw[m][bj] = *(const u32x4*)((const bf16_t*)base + (size_t)(row0 + ai * HALF + m * 16) * DM + col0 + bj * HALF);
#pragma unroll
            for (int m = 0; m < 4; ++m) { const int row = row0 + ai * HALF + m * 16; const size_t off = (size_t)row * DM + col0; float ss = 0.f;
#pragma unroll
                for (int bj = 0; bj < 2; ++bj) { const u32x4 w = bw[m][bj];
                    const f32x4 b0 = {bflo(w.x), bfhi(w.x), bflo(w.y), bfhi(w.y)}, b1 = {bflo(w.z), bfhi(w.z), bflo(w.w), bfhi(w.w)};
                    const f32x4 o0 = b0 + acc[ai][bj][m][0], o1 = b1 + acc[ai][bj][m][1];
                    ss += ((o0[0] * o0[0] + o0[1] * o0[1]) + (o0[2] * o0[2] + o0[3] * o0[3])) + ((o1[0] * o1[0] + o1[1] * o1[1]) + (o1[2] * o1[2] + o1[3] * o1[3]));
                    u32x4 w2; w2.x = cvt_pk_bf16(o0[0], o0[1]); w2.y = cvt_pk_bf16(o0[2], o0[3]); w2.z = cvt_pk_bf16(o1[0], o1[1]); w2.w = cvt_pk_bf16(o1[2], o1[3]);
                    *(u32x4*)(hout + off + bj * HALF) = w2; }
                ss += __shfl_xor(ss, 16); ss += __shfl_xor(ss, 32);
                if (fq == 0) part[(size_t)row * 64 + u.pn * 4 + wc] = ss; }
            asm volatile("" ::: "memory"); }
    }
};
struct EpiResidI8 {
    static constexpr bool PERM = true, AFTER_DRAIN = false;
    const bf16_t* base; bf16_t* hout; float* part; const float* sa; const float* mrow; const float* sw; const float* cw;
    __device__ __forceinline__ void operator()(const i32x4 (&acc)[2][2][4][2], const Unit& u, int wr, int wc, int fr, int fq) const {
        const int row0 = u.pm * BM + wr * 64 + fr, col0 = u.pn * BM + wc * 32 + 8 * fq;
        f32x4 cs[2][2], cc[2][2];
#pragma unroll
        for (int bj = 0; bj < 2; ++bj) { cs[bj][0] = *(const f32x4*)(sw + col0 + bj * HALF); cs[bj][1] = *(const f32x4*)(sw + col0 + bj * HALF + 4); cc[bj][0] = *(const f32x4*)(cw + col0 + bj * HALF); cc[bj][1] = *(const f32x4*)(cw + col0 + bj * HALF + 4); }
#pragma unroll
        for (int ai = 0; ai < 2; ++ai) {
            u32x4 bw[4][2]; float rs[4], rm[4];
#pragma unroll
            for (int m = 0; m < 4; ++m) { rs[m] = sa[row0 + ai * HALF + m * 16]; rm[m] = mrow[row0 + ai * HALF + m * 16];
#pragma unroll
                for (int bj = 0; bj < 2; ++bj) bw[m][bj] = *(const u32x4*)(base + (size_t)(row0 + ai * HALF + m * 16) * DM + col0 + bj * HALF); }
#pragma unroll
            for (int m = 0; m < 4; ++m) { const int row = row0 + ai * HALF + m * 16; const size_t off = (size_t)row * DM + col0; float ss = 0.f;
#pragma unroll
                for (int bj = 0; bj < 2; ++bj) { const u32x4 w = bw[m][bj]; const i32x4 a0 = acc[ai][bj][m][0], a1 = acc[ai][bj][m][1];
                    const f32x4 b0 = {bflo(w.x), bfhi(w.x), bflo(w.y), bfhi(w.y)}, b1 = {bflo(w.z), bfhi(w.z), bflo(w.w), bfhi(w.w)};
                    const f32x4 o0 = b0 + (f32x4){(float)a0[0], (float)a0[1], (float)a0[2], (float)a0[3]} * cs[bj][0] * rs[m] + cc[bj][0] * rm[m];
                    const f32x4 o1 = b1 + (f32x4){(float)a1[0], (float)a1[1], (float)a1[2], (float)a1[3]} * cs[bj][1] * rs[m] + cc[bj][1] * rm[m];
                    ss += ((o0[0] * o0[0] + o0[1] * o0[1]) + (o0[2] * o0[2] + o0[3] * o0[3])) + ((o1[0] * o1[0] + o1[1] * o1[1]) + (o1[2] * o1[2] + o1[3] * o1[3]));
                    u32x4 w2; w2.x = cvt_pk_bf16(o0[0], o0[1]); w2.y = cvt_pk_bf16(o0[2], o0[3]); w2.z = cvt_pk_bf16(o1[0], o1[1]); w2.w = cvt_pk_bf16(o1[2], o1[3]);
                    *(u32x4*)(hout + off + bj * HALF) = w2; }
                ss += __shfl_xor(ss, 16); ss += __shfl_xor(ss, 32);
                if (fq == 0) part[(size_t)row * 64 + u.pn * 4 + wc] = ss; }
            asm volatile("" ::: "memory"); }
    }
};
struct EpiSoftmax {
    static constexpr bool PERM = true, AFTER_DRAIN = true;
    bf16_t* Pm; const float* part;
    __device__ __forceinline__ void fused(f32x4 (&acc)[2][2][4][2], const Unit& u, int wr, int wc, int fr, int fq, LAS unsigned char* lds, int wid, int lane) const {
        LAS float* MX = (LAS float*)lds; LAS float* SM = (LAS float*)(lds + 4096); LAS float* RS = (LAS float*)(lds + 8192);
        const float C = 0.03125f * 1.4426950408889634f;
        { const int tid = wid * 64 + lane, rl = tid >> 1, hf = tid & 1; const f32x4* pp = (const f32x4*)(part + (size_t)(u.pm * BM + rl) * 64 + hf * 32); float s = 0.f;
#pragma unroll
          for (int j = 0; j < 8; ++j) { const f32x4 v = pp[j]; s += (v[0] + v[1]) + (v[2] + v[3]); }
          s += __shfl_xor(s, 1);
          if (hf == 0) RS[rl] = 1.0f / sqrtf(s * (1.0f / DM) + EPS); }
        asm volatile("s_waitcnt lgkmcnt(0)" ::: "memory"); __builtin_amdgcn_s_barrier(); asm volatile("" ::: "memory");
#pragma unroll
        for (int ai = 0; ai < 2; ++ai)
#pragma unroll
            for (int m = 0; m < 4; ++m) { const int r = ai * HALF + wr * 64 + m * 16 + fr; const float sc = RS[r] * C; float mx = -3.0e38f;
#pragma unroll
                for (int bj = 0; bj < 2; ++bj)
#pragma unroll
                    for (int n = 0; n < 2; ++n) { f32x4 v = acc[ai][bj][m][n] * sc; acc[ai][bj][m][n] = v; mx = fmaxf(fmaxf(mx, fmaxf(v[0], v[1])), fmaxf(v[2], v[3])); }
                mx = fmaxf(mx, __shfl_xor(mx, 16)); mx = fmaxf(mx, __shfl_xor(mx, 32));
                if (fq == 0) MX[r * 4 + wc] = mx; }
        asm volatile("s_waitcnt lgkmcnt(0)" ::: "memory"); __builtin_amdgcn_s_barrier(); asm volatile("" ::: "memory");
#pragma unroll
        for (int ai = 0; ai < 2; ++ai)
#pragma unroll
            for (int m = 0; m < 4; ++m) { const int r = ai * HALF + wr * 64 + m * 16 + fr; const f32x4 q = *(const LAS f32x4*)(MX + r * 4); const float M = fmaxf(fmaxf(q[0], q[1]), fmaxf(q[2], q[3])); float s = 0.f;
#pragma unroll
                for (int bj = 0; bj < 2; ++bj)
#pragma unroll
                    for (int n = 0; n < 2; ++n) { f32x4 v = acc[ai][bj][m][n];
#pragma unroll
                        for (int j = 0; j < 4; ++j) { v[j] = __builtin_amdgcn_exp2f(v[j] - M); s += v[j]; }
                        acc[ai][bj][m][n] = v; }
                s += __shfl_xor(s, 16); s += __shfl_xor(s, 32);
                if (fq == 0) SM[r * 4 + wc] = s; }
        asm volatile("s_waitcnt lgkmcnt(0)" ::: "memory"); __builtin_amdgcn_s_barrier(); asm volatile("" ::: "memory");
        const int col0 = u.pn * BM + wc * 32 + 8 * fq;
#pragma unroll
        for (int ai = 0; ai < 2; ++ai)
#pragma unroll
            for (int m = 0; m < 4; ++m) { const int r = ai * HALF + wr * 64 + m * 16 + fr; const f32x4 q = *(const LAS f32x4*)(SM + r * 4); const float inv = 1.0f / ((q[0] + q[1]) + (q[2] + q[3]));
                bf16_t* rowp = Pm + (size_t)(u.pm * BM + r) * 1024 + col0;
#pragma unroll
                for (int bj = 0; bj < 2; ++bj) { const f32x4 v0 = acc[ai][bj][m][0] * inv, v1 = acc[ai][bj][m][1] * inv;
                    u32x4 w; w.x = cvt_pk_bf16(v0[0], v0[1]); w.y = cvt_pk_bf16(v0[2], v0[3]); w.z = cvt_pk_bf16(v1[0], v1[1]); w.w = cvt_pk_bf16(v1[2], v1[3]);
                    *(u32x4*)(rowp + bj * HALF) = w; } }
    }
};
struct QkVoPtrs {
    const char* kcvc; const char* wcq; const char* wcoT; int K, lda, ldb;
    __device__ __forceinline__ const char* a(const Unit& u) const { const int L = u.pm; if (L < 256) { const int bh = L >> 4, b = bh >> 2, h = bh & 3; return kcvc + ((size_t)(b * 256) * 8192 + h * 1024) * 2; }
        const int L2 = L - 256, bh = L2 >> 4, h = bh & 3, nt = L2 & 15; return wcoT + ((size_t)(nt * 256) * 4096 + h * 1024) * 2; }
    __device__ __forceinline__ const char* b(const Unit& u) const { const int L = u.pm; if (L < 256) { const int bh = L >> 4, h = bh & 3, kt = L & 15; return wcq + ((size_t)(kt * 256) * 4096 + h * 1024) * 2; }
        const int L2 = L - 256, bh = L2 >> 4, b = bh >> 2, h = bh & 3; return kcvc + ((size_t)(b * 256) * 8192 + 4096 + h * 1024) * 2; }
};
struct EpiQkVo {
    static constexpr bool PERM = true, AFTER_DRAIN = false;
    bf16_t* WqkT; bf16_t* WvoT;
    __device__ __forceinline__ void operator()(const f32x4 (&acc)[2][2][4][2], const Unit& u, int wr, int wc, int fr, int fq) const {
        const int L = u.pm; bf16_t* base; int ldc;
        if (L < 256) { const int bh = L >> 4, b = bh >> 2, h = bh & 3, kt = L & 15; base = WqkT + ((size_t)(b * 1024 + h * 256)) * 4096 + kt * 256; ldc = 4096; }
        else { const int L2 = L - 256, bh = L2 >> 4, b = bh >> 2, h = bh & 3, nt = L2 & 15; base = WvoT + ((size_t)b * 4096 + nt * 256) * 1024 + h * 256; ldc = 1024; }
        const int row0 = wr * 64 + fr, col0 = wc * 32 + 8 * fq;
#pragma unroll
        for (int ai = 0; ai < 2; ++ai)
#pragma unroll
            for (int m = 0; m < 4; ++m) { bf16_t* rowp = base + (size_t)(row0 + ai * HALF + m * 16) * ldc + col0;
#pragma unroll
                for (int bj = 0; bj < 2; ++bj) { const f32x4 v0 = acc[ai][bj][m][0], v1 = acc[ai][bj][m][1];
                    u32x4 w; w.x = cvt_pk_bf16(v0[0], v0[1]); w.y = cvt_pk_bf16(v0[2], v0[3]); w.z = cvt_pk_bf16(v1[0], v1[1]); w.w = cvt_pk_bf16(v1[2], v1[3]);
                    *(u32x4*)(rowp + bj * HALF) = w; } }
    }
};
}

namespace mb {
constexpr int D = 128, NW = 8, QBLK = 32, KVBLK = 64, QB = NW * QBLK;
constexpr int SHM_V = KVBLK * D * 2, SHM_K = KVBLK * D * 2;
constexpr int KM_OFF = 2 * SHM_V + 2 * SHM_K + NW * 64 * 4;
constexpr int ATT_LDS = KM_OFF + 8192;
constexpr int OSTG_OFF = 77824;
constexpr int LDQ = 128, LDO = DM;
constexpr float SCALE = 0.08838834764831845f;
constexpr float THR = 8.f;
#define KSWZ(row, colB) ((row) * 256 + ((colB) ^ (((row) & 7) << 4)))
#define SBAR() __builtin_amdgcn_sched_barrier(0)
__device__ __forceinline__ int v_st(int k, int c) { const int kk = (k & ~0xC) | ((k & 4) << 1) | ((k & 8) >> 1); return ((kk >> 3) * 4 + (c >> 5)) * 512 + ((kk & 7) * 32 + (c & 31)) * 2; }
__device__ __forceinline__ int v_rd_base(int lane) { return ((lane & 3) << 3) | (((lane >> 2) & 3) << 6) | (((lane >> 4) & 1) << 5) | (((lane >> 5) & 1) << 8); }
constexpr int v_rd_off(int d0, int ks, int half) { return d0 * 512 + ks * 4096 + half * 2048; }
__device__ __forceinline__ int crow(int r, int hi) { return (r & 3) + 8 * (r >> 2) + 4 * hi; }
__device__ __forceinline__ bf16x8 load8(const bf16_t* p) { return *reinterpret_cast<const bf16x8*>(p); }
__device__ __forceinline__ void mask_causal(f32x16& p0, f32x16& p1, int dq) {
    const float NEG = -__builtin_inff();
#pragma unroll
    for (int r = 0; r < 16; ++r) {
        const int c = (r & 3) + 8 * (r >> 2);
        if (dq - c < 0) p0[r] = NEG;
        if (dq - c - 32 < 0) p1[r] = NEG;
    }
}
__device__ __forceinline__ void partialSM(f32x16& p0, f32x16& p1, float& m_reg, float& mn, float& alpha, bool allow) {
    float pmax = p0[0];
#pragma unroll
    for (int r = 1; r < 16; ++r) pmax = fmaxf(pmax, p0[r]);
#pragma unroll
    for (int r = 0; r < 16; ++r) pmax = fmaxf(pmax, p1[r]);
    { auto rr = __builtin_amdgcn_permlane32_swap(__float_as_uint(pmax), __float_as_uint(pmax), false, false);
      pmax = fmaxf(__uint_as_float(rr[0]), __uint_as_float(rr[1])); }
    pmax = allow ? pmax : -__builtin_inff();
    constexpr float C2 = 1.4426950408889634f * SCALE;
    if (__builtin_expect(__all((pmax - m_reg) * SCALE <= THR), 1)) { mn = m_reg; alpha = 1.f; }
    else { mn = fmaxf(m_reg, pmax); alpha = __builtin_amdgcn_exp2f((m_reg - mn) * C2); m_reg = mn; }
    const float mnL = allow ? -mn * C2 : -__builtin_inff();
#pragma unroll
    for (int r = 0; r < 16; ++r) p0[r] = fmaf(p0[r], C2, mnL);
#pragma unroll
    for (int r = 0; r < 16; ++r) p1[r] = fmaf(p1[r], C2, mnL);
#pragma unroll
    for (int r = 0; r < 16; ++r) p0[r] = __builtin_amdgcn_exp2f(p0[r]);
}
__device__ __forceinline__ void finishSM(f32x16& p0, f32x16& p1, float alpha, float& l_reg, bf16x8& pa0, bf16x8& pa1, bf16x8& pa2, bf16x8& pa3) {
#pragma unroll
    for (int r = 0; r < 16; ++r) p1[r] = __builtin_amdgcn_exp2f(p1[r]);
    float ps = 0;
#pragma unroll
    for (int r = 0; r < 16; ++r) ps += p0[r];
#pragma unroll
    for (int r = 0; r < 16; ++r) ps += p1[r];
    { auto rr = __builtin_amdgcn_permlane32_swap(__float_as_uint(ps), __float_as_uint(ps), false, false);
      ps = __uint_as_float(rr[0]) + __uint_as_float(rr[1]); }
    l_reg = l_reg * alpha + ps;
#define PK4(P, B_, OUT) do { unsigned a0 = cvt_pk_bf16(P[B_+0], P[B_+1]), a1 = cvt_pk_bf16(P[B_+2], P[B_+3]);                          \
        unsigned b0 = cvt_pk_bf16(P[B_+4], P[B_+5]), b1 = cvt_pk_bf16(P[B_+6], P[B_+7]);                                             \
        auto r0 = __builtin_amdgcn_permlane32_swap(a0, b0, false, false); auto r1 = __builtin_amdgcn_permlane32_swap(a1, b1, false, false); \
        u32x4 w = {r0[0], r1[0], r0[1], r1[1]}; OUT = *reinterpret_cast<bf16x8*>(&w); } while (0)
    PK4(p0, 0, pa0); PK4(p0, 8, pa1); PK4(p1, 0, pa2); PK4(p1, 8, pa3);
#undef PK4
}
template <int KB>
__device__ __forceinline__ void qkt(f32x16& p0, f32x16& p1, const char* K_lds, int r32, int hi, const bf16x8* qr) {
    p0 = f32x16{}; p1 = f32x16{};
    const char* kb[4];
#pragma unroll
    for (int dd = 0; dd < 4; ++dd) kb[dd] = K_lds + KB * SHM_K + KSWZ(r32, (dd * 16 + hi * 8) * 2);
#pragma unroll
    for (int d0 = 0; d0 < 8; ++d0) { const char* a = kb[d0 & 3] + (d0 >> 2) * 128;
        bf16x8 b0 = *reinterpret_cast<const bf16x8*>(a);
        bf16x8 b1 = *reinterpret_cast<const bf16x8*>(a + 32 * 256);
        p0 = __builtin_amdgcn_mfma_f32_32x32x16_bf16(b0, qr[d0], p0, 0, 0, 0);
        p1 = __builtin_amdgcn_mfma_f32_32x32x16_bf16(b1, qr[d0], p1, 0, 0, 0); }
}
template <int VB>
__device__ __forceinline__ void pv_tile(f32x16* o, int vb0, bf16x8 pa0, bf16x8 pa1, bf16x8 pa2, bf16x8 pa3) {
#define TRRD(dst, off) asm volatile("ds_read_b64_tr_b16 %0, %1 offset:%2" : "=&v"(dst) : "v"(vb0), "i"(off) : "memory")
#define PV_D0(d0) do { s16x4 l0, l1, l2, l3, h0, h1, h2, h3; constexpr int b_ = VB * SHM_V + v_rd_off(d0, 0, 0); \
        TRRD(l0, b_); TRRD(h0, b_ + 2048); TRRD(l1, b_ + 4096); TRRD(h1, b_ + 6144); TRRD(l2, b_ + 8192); TRRD(h2, b_ + 10240); TRRD(l3, b_ + 12288); TRRD(h3, b_ + 14336); \
        asm volatile("s_waitcnt lgkmcnt(0)" ::: "memory"); SBAR();   \
        o[d0] = __builtin_amdgcn_mfma_f32_32x32x16_bf16(pa0, (bf16x8){l0[0], l0[1], l0[2], l0[3], h0[0], h0[1], h0[2], h0[3]}, o[d0], 0, 0, 0);   \
        o[d0] = __builtin_amdgcn_mfma_f32_32x32x16_bf16(pa1, (bf16x8){l1[0], l1[1], l1[2], l1[3], h1[0], h1[1], h1[2], h1[3]}, o[d0], 0, 0, 0);   \
        o[d0] = __builtin_amdgcn_mfma_f32_32x32x16_bf16(pa2, (bf16x8){l2[0], l2[1], l2[2], l2[3], h2[0], h2[1], h2[2], h2[3]}, o[d0], 0, 0, 0);   \
        o[d0] = __builtin_amdgcn_mfma_f32_32x32x16_bf16(pa3, (bf16x8){l3[0], l3[1], l3[2], l3[3], h3[0], h3[1], h3[2], h3[3]}, o[d0], 0, 0, 0); } while (0)
    PV_D0(0); PV_D0(1); PV_D0(2); PV_D0(3);
#undef PV_D0
#undef TRRD
}
struct BlockRef { const bf16_t* Q; const bf16_t* K; const bf16_t* V; bf16_t* O; const float* km; int qb; };
struct Seam { bf16x8 qr[8]; bf16x8 st_v0, st_v1, st_k0, st_k1; };
#define ROWU(p, k0, half) ((const bf16_t*)((const char*)(p) + (size_t)((k0) + (half) * 32) * (LDQ * 2) + lane_ld))
#define VMW() asm volatile("s_waitcnt vmcnt(0)" ::: "memory")
#define VMWN(n) asm volatile("s_waitcnt vmcnt(%0)" :: "i"(n) : "memory")
#define SLOAD_H(Kp, Vp, k0) do { S.st_v0 = load8(ROWU(Vp, k0, 0)); S.st_v1 = load8(ROWU(Vp, k0, 1));              \
                         S.st_k0 = load8(ROWU(Kp, k0, 0)); S.st_k1 = load8(ROWU(Kp, k0, 1)); } while (0)
#define SWRITE_HK(bf) do { *(bf16x8*)(K_lds + (bf) * SHM_K + kws) = S.st_k0; *(bf16x8*)(K_lds + (bf) * SHM_K + kws + 32 * 256) = S.st_k1; } while (0)
#define SWRITE_HV(bf) do { *(bf16x8*)(V_lds + (bf) * SHM_V + vst0) = S.st_v0; *(bf16x8*)(V_lds + (bf) * SHM_V + vst1) = S.st_v1; } while (0)
#define SWRITE_H(bf) do { SWRITE_HV(bf); SWRITE_HK(bf); } while (0)
__device__ __forceinline__ void moba_prime(const BlockRef& cur, char* lds, Seam& S) {
    int tid_ = threadIdx.x; asm volatile("" : "+v"(tid_));
    const int tid = tid_, wid = __builtin_amdgcn_readfirstlane(tid >> 6), lane = tid & 63, r32 = lane & 31, hi = lane >> 5;
    const int sr = tid >> 4, sc = (tid & 15) * 8, kws = KSWZ(sr, sc * 2); char* K_lds = lds + 2 * SHM_V;
    const unsigned lane_ld = (unsigned)((sr * LDQ + sc) * 2);
#pragma unroll
    for (int d0 = 0; d0 < 8; ++d0) S.qr[d0] = load8(cur.Q + (size_t)(wid * QBLK + r32) * LDQ + d0 * 16 + hi * 8);
    SLOAD_H(cur.K, cur.V, 0); VMW(); SWRITE_HK(0);
    __syncthreads();
}
__device__ __forceinline__ void moba_block(const BlockRef& cur, const BlockRef& nxt, char* lds, Seam& S) {
    int tid_ = threadIdx.x; asm volatile("" : "+v"(tid_));
    const int tid = tid_, wid = __builtin_amdgcn_readfirstlane(tid >> 6), lane = tid & 63, r32 = lane & 31, hi = lane >> 5;
    const int qb = cur.qb, P0 = qb * QB;
    const int NT = (P0 + QB) / KVBLK;
    const int qlo = P0 + wid * QBLK, qm = qlo + r32 - 4 * hi;
    char* V_lds = lds; char* K_lds = lds + 2 * SHM_V;
    float* ws = (float*)(lds + 2 * SHM_V + 2 * SHM_K) + wid * 64; float* li_l = ws, * al_l = ws + 32;
    float* KM = (float*)(lds + KM_OFF);
    *(f32x4*)(KM + tid * 4) = *(const f32x4*)(cur.km + tid * 4);
    __syncthreads();
    unsigned mrow;
    if (qb <= 3) mrow = (2u << qb) - 1u;
    else {
        float g[15];
#pragma unroll
        for (int n = 0; n < 15; ++n) { g[n] = -__builtin_inff();
            if (n < qb) { float a = 0.f; const float* km = KM + n * 128 + hi * 8;
#pragma unroll
                for (int d0 = 0; d0 < 8; ++d0) { const bf16x8 q = S.qr[d0]; const f32x4 k0 = *(const f32x4*)(km + d0 * 16), k1 = *(const f32x4*)(km + d0 * 16 + 4);
                    a += bf2f((unsigned short)q[0]) * k0[0]; a += bf2f((unsigned short)q[1]) * k0[1]; a += bf2f((unsigned short)q[2]) * k0[2]; a += bf2f((unsigned short)q[3]) * k0[3];
                    a += bf2f((unsigned short)q[4]) * k1[0]; a += bf2f((unsigned short)q[5]) * k1[1]; a += bf2f((unsigned short)q[6]) * k1[2]; a += bf2f((unsigned short)q[7]) * k1[3]; }
                a += __shfl_xor(a, 32); g[n] = a; } }
        unsigned taken = 0u;
#pragma unroll
        for (int rep = 0; rep < 3; ++rep) { float best = -__builtin_inff(); int bi = 0;
#pragma unroll
            for (int n = 0; n < 15; ++n) { const bool c = (g[n] > best); best = c ? g[n] : best; bi = c ? n : bi; }
            taken |= 1u << bi;
#pragma unroll
            for (int n = 0; n < 15; ++n) g[n] = (n == bi) ? -__builtin_inff() : g[n]; }
        mrow = taken | (1u << qb);
    }
    float m_reg = -1e30f, l_reg = 0; f32x16 o[4] = {};
    const int sr = tid >> 4, sc = (tid & 15) * 8, vst0 = v_st(sr, sc), vst1 = v_st(32 + sr, sc), kws = KSWZ(sr, sc * 2);
    const unsigned lane_ld = (unsigned)((sr * LDQ + sc) * 2);
    const int vb0 = (int)(uintptr_t)V_lds + v_rd_base(lane);
    const bf16_t* Kh = cur.K; const bf16_t* Vh = cur.V;
#define RESC(a) do { if (__any((a) < 1.f)) { if (hi == 0) al_l[r32] = (a); asm volatile("s_waitcnt lgkmcnt(0)" ::: "memory");              \
                     for (int d_ = 0; d_ < 4; ++d_) for (int r = 0; r < 16; ++r) o[d_][r] *= al_l[crow(r, hi)]; } } while (0)
#define KBASE(t) ((t) * KVBLK)
#define MASKT(P0_, P1_, t) do { if (((t) >> 2) == qb) { if (KBASE(t) + KVBLK - 1 > qlo) mask_causal(P0_, P1_, qm - KBASE(t)); } } while (0)
#define ALLOWT(t) (((mrow >> ((t) >> 2)) & 1u) != 0u)
    constexpr int NQL = 8;
#define SEAM_K0() do { VMWN(NQL); SWRITE_HK(0); SBAR(); } while (0)
    f32x16 pA0, pA1, pB0, pB1; float mnA, mnB, alA, alB; bf16x8 pa0, pa1, pa2, pa3;
    SWRITE_HV(0); SBAR();
    if (NT > 1) SLOAD_H(Kh, Vh, KBASE(1));
    SBAR(); qkt<0>(pA0, pA1, K_lds, r32, hi, S.qr);
    MASKT(pA0, pA1, 0); partialSM(pA0, pA1, m_reg, mnA, alA, ALLOWT(0));
    if (NT > 1) { VMW(); SWRITE_H(1); }
    __syncthreads();
#define HALF_STEP(PX0, PX1, mnX, alX, PY0, PY1, alY, t, KB, VB, SB) do {                                                      \
        SBAR(); qkt<KB>(PX0, PX1, K_lds, r32, hi, S.qr);                                             \
        finishSM(PY0, PY1, alY, l_reg, pa0, pa1, pa2, pa3); SBAR();                                                           \
        if ((t) + 1 < NT) { SLOAD_H(Kh, Vh, KBASE((t) + 1)); SBAR(); }                                               \
        pv_tile<VB>(o, vb0, pa0, pa1, pa2, pa3); MASKT(PX0, PX1, (t)); partialSM(PX0, PX1, m_reg, mnX, alX, ALLOWT(t));                                        \
        __syncthreads();                                                                                                      \
        if ((t) + 1 < NT) { VMW(); SWRITE_H(SB); }                                                                          \
        RESC(alX); __syncthreads(); } while (0)
    if (wid >= 4) __builtin_amdgcn_s_setprio(1);
    for (int t = 1; t + 1 < NT; t += 2) {
        HALF_STEP(pB0, pB1, mnB, alB, pA0, pA1, alA, t, 1, 0, 0);
        HALF_STEP(pA0, pA1, mnA, alA, pB0, pB1, alB, t + 1, 0, 1, 1);
    }
    __builtin_amdgcn_s_setprio(0);
    SBAR(); qkt<1>(pB0, pB1, K_lds, r32, hi, S.qr); SBAR();
    SLOAD_H(nxt.K, nxt.V, 0); SBAR();
#pragma unroll
    for (int d0 = 0; d0 < 8; ++d0) S.qr[d0] = load8(nxt.Q + (size_t)(wid * QBLK + r32) * LDQ + d0 * 16 + hi * 8);
    SBAR();
    finishSM(pA0, pA1, alA, l_reg, pa0, pa1, pa2, pa3); SBAR();
    pv_tile<0>(o, vb0, pa0, pa1, pa2, pa3);
    MASKT(pB0, pB1, NT - 1); partialSM(pB0, pB1, m_reg, mnB, alB, true); __syncthreads(); RESC(alB);
    finishSM(pB0, pB1, alB, l_reg, pa0, pa1, pa2, pa3); SBAR(); pv_tile<1>(o, vb0, pa0, pa1, pa2, pa3);
    SBAR(); SEAM_K0();
    if (hi == 0) li_l[r32] = l_reg; asm volatile("s_waitcnt lgkmcnt(0)" ::: "memory");
    float rli[16];
#pragma unroll
    for (int r = 0; r < 16; ++r) rli[r] = __builtin_amdgcn_rcpf(li_l[crow(r, hi)]);
    char* Ow = (char*)(cur.O + (size_t)(wid * QBLK) * LDO);
    char* stg = lds + OSTG_OFF + wid * 4608;
    unsigned st_w = (unsigned)(4 * hi * 144 + r32 * 2), st_r = (unsigned)((lane >> 3) * 144 + (lane & 7) * 16), g_off = (unsigned)((lane >> 3) * (LDO * 2) + (lane & 7) * 16);
    asm volatile("" : "+v"(st_w), "+v"(st_r), "+v"(g_off));
#pragma unroll
    for (int h2 = 0; h2 < 2; ++h2) {
#pragma unroll
        for (int r = 0; r < 16; ++r)
#pragma unroll
            for (int dd = 0; dd < 2; ++dd) { const float v = o[2 * h2 + dd][r] * rli[r]; const float vn = __shfl_xor(v, 1);
                if ((r32 & 1) == 0) *(unsigned*)(stg + ((r & 3) + 8 * (r >> 2)) * 144 + dd * 64 + st_w) = cvt_pk_bf16(v, vn); }
        asm volatile("s_waitcnt lgkmcnt(0)" ::: "memory");
#pragma unroll
        for (int j = 0; j < 4; ++j) { const u32x4 w = *(const u32x4*)(stg + j * 8 * 144 + st_r); *(u32x4*)(Ow + (size_t)j * 8 * (LDO * 2) + h2 * 128 + g_off) = w; }
        asm volatile("s_waitcnt lgkmcnt(0)" ::: "memory");
    }
    __syncthreads();
#undef RESC
#undef KBASE
#undef MASKT
#undef ALLOWT
#undef SEAM_K0
#undef HALF_STEP
}
#undef ROWU
#undef VMW
#undef VMWN
#undef SLOAD_H
#undef SWRITE_HK
#undef SWRITE_HV
#undef SWRITE_H
}


namespace gla {
constexpr int L_SEG = 0, L_BT = 2048;
constexpr int GA_E = 4096, GA_KI = 38912, GA_VT = 55296;
constexpr int L_QD = 4096, L_KI = L_QD + 17408, L_VT = 38912, L_AT = 71680, L_OT = 4096;
__device__ __forceinline__ int crow(int r, int hi) { return (r & 3) + 8 * (r >> 2) + 4 * hi; }
__device__ __forceinline__ unsigned short f2bf1(float x) { return (unsigned short)(cvt_pk_bf16(x, 0.f) & 0xffffu); }
#define GLA_TRRD(dst, base, off) asm volatile("ds_read_b64_tr_b16 %0, %1 offset:%2" : "=&v"(dst) : "v"(base), "i"(off) : "memory")
#define GLA_FRAG(dst, base, d0, ks) do { s16x4 l_, h_; GLA_TRRD(l_, base, (d0) * 512 + (ks) * 4096); GLA_TRRD(h_, base, (d0) * 512 + (ks) * 4096 + 2048); \
        asm volatile("s_waitcnt lgkmcnt(0)" ::: "memory"); __builtin_amdgcn_sched_barrier(0); dst = (bf16x8){l_[0], l_[1], l_[2], l_[3], h_[0], h_[1], h_[2], h_[3]}; } while (0)
__device__ __forceinline__ float prep_b(LAS unsigned char* lds, const float* glow_rows, const float (&wg)[16], float bg, int k, int seg, float (&bv)[16]) {
    float cum = 0.f;
#pragma unroll
    for (int j = 0; j < 16; ++j) { const float* gl = glow_rows + (16 * seg + j) * 16; float z = bg;
#pragma unroll
        for (int r = 0; r < 16; ++r) z += gl[r] * wg[r];
        const float ls = fminf(z, 0.f) - __logf(1.0f + __expf(-fabsf(z)));
        cum += ls * (1.0f / 16.0f); bv[j] = cum; }
    LAS float* SEG = (LAS float*)(lds + L_SEG);
    SEG[seg * 128 + k] = cum;
    __syncthreads();
    float pre = 0.f, tot = 0.f;
#pragma unroll
    for (int s2 = 0; s2 < 4; ++s2) { const float v = SEG[s2 * 128 + k]; tot += v; pre += (s2 < seg) ? v : 0.f; }
#pragma unroll
    for (int j = 0; j < 16; ++j) bv[j] += pre;
    if (seg == 0) ((LAS float*)(lds + L_BT))[k] = __expf(tot);
    return tot;
}
__device__ __forceinline__ void load_v(u32x4 (&vr)[4], const bf16_t* vsrc, int tid) {
    const int t = tid >> 3, v0 = (tid & 7) * 32;
#pragma unroll
    for (int j = 0; j < 4; ++j) vr[j] = *(const u32x4*)(vsrc + (size_t)t * PROJ_LD + v0 + 8 * j);
}
__device__ __forceinline__ void store_v(LAS unsigned char* lds, int off, const u32x4 (&vr)[4], int tid) {
    const int t = tid >> 3, v0 = (tid & 7) * 32;
#pragma unroll
    for (int j = 0; j < 4; ++j) { const int c = v0 + 8 * j; *(LAS u32x4*)(lds + off + (c >> 7) * 16384 + mb::v_st(t, c & 127)) = vr[j]; }
}
__device__ __forceinline__ void ga_unit(LAS unsigned char* lds, int unit, bf16_t* proj, const float* glow, const float* w_gate_up, const float* b_gate, bf16_t* dSt, float* decay, int tid, int wave, int lane) {
    const int n = unit & 63, bh = unit >> 6, b = bh >> 3, h = bh & 7;
    const size_t row0 = (size_t)b * SEQ + n * 64;
    const int k = tid & 127, seg = __builtin_amdgcn_readfirstlane(tid >> 7);
    const int t = tid >> 3, c0 = (tid & 7) * 16;
    bf16_t* qp = proj + (row0 + t) * PROJ_LD + C_GQ + h * 128 + c0; bf16_t* kp = qp + (C_GK - C_GQ);
    const u32x4 q0 = *(const u32x4*)qp, q1 = *(const u32x4*)(qp + 8), k0 = *(const u32x4*)kp, k1 = *(const u32x4*)(kp + 8);
    u32x4 vr[4]; load_v(vr, proj + row0 * PROJ_LD + C_GV + h * 256, tid);
    float wg[16];
#pragma unroll
    for (int r = 0; r < 16; ++r) wg[r] = w_gate_up[r * 1024 + h * 128 + k];
    float bv[16];
    const float tot = prep_b(lds, glow + row0 * 16, wg, b_gate[h * 128 + k], k, seg, bv);
#pragma unroll
    for (int j = 0; j < 16; ++j) *(LAS float*)(lds + GA_E + ((16 * seg + j) * 132 + k) * 4) = __expf(bv[j]);
    if (seg == 0) decay[(size_t)unit * 128 + k] = __expf(tot);
    store_v(lds, GA_VT, vr, tid);
    __syncthreads();
    {
        const LAS f32x4* ep = (const LAS f32x4*)(lds + GA_E + (t * 132 + c0) * 4); f32x4 e[4];
#pragma unroll
        for (int i = 0; i < 4; ++i) e[i] = ep[i];
        const unsigned qw[8] = {q0.x, q0.y, q0.z, q0.w, q1.x, q1.y, q1.z, q1.w}, kw[8] = {k0.x, k0.y, k0.z, k0.w, k1.x, k1.y, k1.z, k1.w}; unsigned qo[8], ko[8];
#pragma unroll
        for (int i = 0; i < 8; ++i) { const float e0 = e[i >> 1][(i & 1) * 2], e1 = e[i >> 1][(i & 1) * 2 + 1];
            qo[i] = cvt_pk_bf16(bflo(qw[i]) * 0.08838834764831845f * e0, bfhi(qw[i]) * 0.08838834764831845f * e1);
            ko[i] = cvt_pk_bf16(bflo(kw[i]) * __builtin_amdgcn_rcpf(e0), bfhi(kw[i]) * __builtin_amdgcn_rcpf(e1)); }
        const u32x4 qa = {qo[0], qo[1], qo[2], qo[3]}, qb = {qo[4], qo[5], qo[6], qo[7]}, ka = {ko[0], ko[1], ko[2], ko[3]}, kb = {ko[4], ko[5], ko[6], ko[7]};
        *(u32x4*)qp = qa; *(u32x4*)(qp + 8) = qb; *(u32x4*)kp = ka; *(u32x4*)(kp + 8) = kb;
        *(LAS u32x4*)(lds + GA_KI + mb::v_st(t, c0)) = ka; *(LAS u32x4*)(lds + GA_KI + mb::v_st(t, c0 + 8)) = kb;
    }
    __syncthreads();
    const int r = lane & 31, hh = lane >> 5;
    const int kbase = (int)(uintptr_t)(lds + GA_KI) + mb::v_rd_base(lane), vbase = (int)(uintptr_t)(lds + GA_VT + (wave >> 2) * 16384) + mb::v_rd_base(lane);
    bf16x8 vf[4];
    switch (wave & 3) {
        case 0: GLA_FRAG(vf[0], vbase, 0, 0); GLA_FRAG(vf[1], vbase, 0, 1); GLA_FRAG(vf[2], vbase, 0, 2); GLA_FRAG(vf[3], vbase, 0, 3); break;
        case 1: GLA_FRAG(vf[0], vbase, 1, 0); GLA_FRAG(vf[1], vbase, 1, 1); GLA_FRAG(vf[2], vbase, 1, 2); GLA_FRAG(vf[3], vbase, 1, 3); break;
        case 2: GLA_FRAG(vf[0], vbase, 2, 0); GLA_FRAG(vf[1], vbase, 2, 1); GLA_FRAG(vf[2], vbase, 2, 2); GLA_FRAG(vf[3], vbase, 2, 3); break;
        default: GLA_FRAG(vf[0], vbase, 3, 0); GLA_FRAG(vf[1], vbase, 3, 1); GLA_FRAG(vf[2], vbase, 3, 2); GLA_FRAG(vf[3], vbase, 3, 3); break;
    }
    bf16_t* ob = dSt + ((size_t)unit * 256 + 32 * wave + r) * 128 + 8 * hh;
#define GA_KB(kb_) do { f32x16 acc = {}; bf16x8 kf; \
        GLA_FRAG(kf, kbase, kb_, 0); acc = __builtin_amdgcn_mfma_f32_32x32x16_bf16(kf, vf[0], acc, 0, 0, 0); GLA_FRAG(kf, kbase, kb_, 1); acc = __builtin_amdgcn_mfma_f32_32x32x16_bf16(kf, vf[1], acc, 0, 0, 0); \
        GLA_FRAG(kf, kbase, kb_, 2); acc = __builtin_amdgcn_mfma_f32_32x32x16_bf16(kf, vf[2], acc, 0, 0, 0); GLA_FRAG(kf, kbase, kb_, 3); acc = __builtin_amdgcn_mfma_f32_32x32x16_bf16(kf, vf[3], acc, 0, 0, 0); \
          \
        u32x2 w[4]; \
        _Pragma("unroll") for (int g4 = 0; g4 < 4; ++g4) { const f32x4 dk = *(const LAS f32x4*)(lds + L_BT + ((kb_) * 32 + 8 * g4 + 4 * hh) * 4); \
            w[g4].x = cvt_pk_bf16(acc[4 * g4] * dk[0], acc[4 * g4 + 1] * dk[1]); w[g4].y = cvt_pk_bf16(acc[4 * g4 + 2] * dk[2], acc[4 * g4 + 3] * dk[3]); } \
        _Pragma("unroll") for (int p = 0; p < 2; ++p) { auto rx = __builtin_amdgcn_permlane32_swap(w[2 * p].x, w[2 * p + 1].x, false, false); auto ry = __builtin_amdgcn_permlane32_swap(w[2 * p].y, w[2 * p + 1].y, false, false); \
            u32x4 o4 = {rx[0], ry[0], rx[1], ry[1]}; *(u32x4*)(ob + (kb_) * 32 + 16 * p) = o4; } } while (0)
    GA_KB(0); GA_KB(1); GA_KB(2); GA_KB(3);
#undef GA_KB
    __syncthreads();
}
__device__ __forceinline__ void gc_unit(LAS unsigned char* lds, int unit, const bf16_t* proj, const bf16_t* dSt, const float* gnorm, bf16_t* omix, int tid, int wave, int lane) {
    const int n = unit & 63, bh = unit >> 6, b = bh >> 3, h = bh & 7;
    const size_t row0 = (size_t)b * SEQ + n * 64;
    bf16x8 sfr[8];
    { const bf16_t* sp = dSt + ((size_t)unit * 256 + 32 * wave + (lane & 31)) * 128 + (lane >> 5) * 8;
#pragma unroll
      for (int ks = 0; ks < 8; ++ks) sfr[ks] = *(const bf16x8*)(sp + ks * 16); }
    { const int t = tid >> 3, c0 = (tid & 7) * 16; const bf16_t* qp = proj + (row0 + t) * PROJ_LD + C_GQ + h * 128 + c0;
      const u32x4 q0 = *(const u32x4*)qp, q1 = *(const u32x4*)(qp + 8), k0 = *(const u32x4*)(qp + (C_GK - C_GQ)), k1 = *(const u32x4*)(qp + (C_GK - C_GQ) + 8);
      u32x4 vr[4]; load_v(vr, proj + row0 * PROJ_LD + C_GV + h * 256, tid);
      *(LAS u32x4*)(lds + L_QD + t * 272 + c0 * 2) = q0; *(LAS u32x4*)(lds + L_QD + t * 272 + c0 * 2 + 16) = q1;
      *(LAS u32x4*)(lds + L_KI + t * 272 + c0 * 2) = k0; *(LAS u32x4*)(lds + L_KI + t * 272 + c0 * 2 + 16) = k1;
      store_v(lds, L_VT, vr, tid); }
    __syncthreads();
    const int r = lane & 31, hh = lane >> 5;
    if (wave < 4) { const int ct = wave & 1, st = wave >> 1; f32x16 acc = {};
#pragma unroll
        for (int ks = 0; ks < 8; ++ks) { const bf16x8 a = *(const LAS bf16x8*)(lds + L_QD + (ct * 32 + r) * 272 + ks * 32 + hh * 16), bb = *(const LAS bf16x8*)(lds + L_KI + (st * 32 + r) * 272 + ks * 32 + hh * 16);
            acc = __builtin_amdgcn_mfma_f32_32x32x16_bf16(a, bb, acc, 0, 0, 0); }
#pragma unroll
        for (int i = 0; i < 16; ++i) { const int c = ct * 32 + crow(i, hh), s2 = st * 32 + r; const float val = (s2 <= c) ? acc[i] : 0.f;
            *(LAS unsigned short*)(lds + L_AT + c * 144 + s2 * 2) = f2bf1(val); } }
    __syncthreads();
    f32x16 o0 = {}, o1 = {};
    { const int vbase = (int)(uintptr_t)(lds + L_VT + (wave >> 2) * 16384) + mb::v_rd_base(lane); bf16x8 vf[4];
      switch (wave & 3) {
          case 0: GLA_FRAG(vf[0], vbase, 0, 0); GLA_FRAG(vf[1], vbase, 0, 1); GLA_FRAG(vf[2], vbase, 0, 2); GLA_FRAG(vf[3], vbase, 0, 3); break;
          case 1: GLA_FRAG(vf[0], vbase, 1, 0); GLA_FRAG(vf[1], vbase, 1, 1); GLA_FRAG(vf[2], vbase, 1, 2); GLA_FRAG(vf[3], vbase, 1, 3); break;
          case 2: GLA_FRAG(vf[0], vbase, 2, 0); GLA_FRAG(vf[1], vbase, 2, 1); GLA_FRAG(vf[2], vbase, 2, 2); GLA_FRAG(vf[3], vbase, 2, 3); break;
          default: GLA_FRAG(vf[0], vbase, 3, 0); GLA_FRAG(vf[1], vbase, 3, 1); GLA_FRAG(vf[2], vbase, 3, 2); GLA_FRAG(vf[3], vbase, 3, 3); break;
      }
#pragma unroll
      for (int ss = 0; ss < 4; ++ss) { const bf16x8 a0 = *(const LAS bf16x8*)(lds + L_AT + r * 144 + ss * 32 + hh * 16), a1 = *(const LAS bf16x8*)(lds + L_AT + (32 + r) * 144 + ss * 32 + hh * 16);
          o0 = __builtin_amdgcn_mfma_f32_32x32x16_bf16(a0, vf[ss], o0, 0, 0, 0); o1 = __builtin_amdgcn_mfma_f32_32x32x16_bf16(a1, vf[ss], o1, 0, 0, 0); } }
    {
#pragma unroll
      for (int ks = 0; ks < 8; ++ks) { const bf16x8 bb = sfr[ks];
          const bf16x8 a0 = *(const LAS bf16x8*)(lds + L_QD + r * 272 + ks * 32 + hh * 16), a1 = *(const LAS bf16x8*)(lds + L_QD + (32 + r) * 272 + ks * 32 + hh * 16);
          o0 = __builtin_amdgcn_mfma_f32_32x32x16_bf16(a0, bb, o0, 0, 0, 0); o1 = __builtin_amdgcn_mfma_f32_32x32x16_bf16(a1, bb, o1, 0, 0, 0); } }
    __syncthreads();
#pragma unroll
    for (int i = 0; i < 16; ++i) { const int c = crow(i, hh); *(LAS float*)(lds + L_OT + c * 1040 + (32 * wave + r) * 4) = o0[i]; *(LAS float*)(lds + L_OT + (32 + c) * 1040 + (32 * wave + r) * 4) = o1[i]; }
    __syncthreads();
    const f32x4 g = *((const f32x4*)gnorm + lane);
#pragma unroll
    for (int rr = 0; rr < 8; ++rr) { const int c = 8 * wave + rr; const f32x4 v = *(const LAS f32x4*)(lds + L_OT + c * 1040 + lane * 16);
        float ss = (v[0] * v[0] + v[1] * v[1]) + (v[2] * v[2] + v[3] * v[3]);
#pragma unroll
        for (int o = 1; o < 64; o <<= 1) ss += __shfl_xor(ss, o);
        const float rs = 1.0f / sqrtf(ss * (1.0f / 256.0f) + EPS);
        const u32x2 gw2 = *((const u32x2*)(proj + (row0 + c) * PROJ_LD + C_GOUT + h * 256) + lane);
        const float z0 = bflo(gw2.x), z1 = bfhi(gw2.x), z2 = bflo(gw2.y), z3 = bfhi(gw2.y);
        const float p0 = v[0] * rs * g[0] * (z0 / (1.0f + __expf(-z0))), p1 = v[1] * rs * g[1] * (z1 / (1.0f + __expf(-z1)));
        const float p2 = v[2] * rs * g[2] * (z2 / (1.0f + __expf(-z2))), p3 = v[3] * rs * g[3] * (z3 / (1.0f + __expf(-z3)));
        u32x2 w; w.x = cvt_pk_bf16(p0, p1); w.y = cvt_pk_bf16(p2, p3); *((u32x2*)(omix + (row0 + c) * DM + h * 256) + lane) = w; }
    __syncthreads();
}
#undef GLA_FRAG
#undef GLA_TRRD
}

constexpr int NWAVES = 8;
constexpr int RING_BYTES = 131072;
constexpr int LDSCTL_OFF = 143360, MISC_OFF = LDSCTL_OFF + 320;
constexpr int LDS_BYTES = 147456;
constexpr int CW_BAR = 4096;
constexpr int NPHASE = 14;

typedef GAS unsigned gu32;
#define RLX_AGENT __ATOMIC_RELAXED, __HIP_MEMORY_SCOPE_AGENT
#define LDS_WAIT() asm volatile("s_waitcnt lgkmcnt(0)" ::: "memory")
#define VM_WAIT() asm volatile("s_waitcnt vmcnt(0)" ::: "memory")

#define XB_TMO      128
#define XB_XCNT(j)  (256  + 64 * (j))
#define XB_XSUB(j)  (1280 + 64 * (j))
#define XB_XGEN(j)  (2304 + 64 * (j))
#define XB_TOP      3328
#define XB_TOPGEN   3392
#define XCD_BAR_WORDS 3456
#define XB_SPIN_CAP (1u << 18)
__device__ __forceinline__ unsigned xb_ld(unsigned* p)              { return __hip_atomic_load(p, __ATOMIC_RELAXED, __HIP_MEMORY_SCOPE_AGENT); }
__device__ __forceinline__ unsigned xb_add(unsigned* p, unsigned v) { return __hip_atomic_fetch_add(p, v, __ATOMIC_RELAXED, __HIP_MEMORY_SCOPE_AGENT); }
__device__ __forceinline__ unsigned xb_xcc_id() { return (unsigned)__builtin_amdgcn_s_getreg((3 << 11) | 20) & 0xFu; }
#define XB_SPIN(cond, bar) do { unsigned _sp = 0; while (cond) { __builtin_amdgcn_s_sleep(1); \
    if ((++_sp & 255u) == 0u) { if (xb_ld(&(bar)[XB_TMO])) break; if (_sp > XB_SPIN_CAP) { atomicAdd(&(bar)[XB_TMO], 1u); break; } } } } while (0)
struct XcdBarrier { unsigned* bar; unsigned x; volatile LAS unsigned* st; };
__device__ __forceinline__ XcdBarrier xcd_barrier_post(unsigned* bar, volatile LAS unsigned* st) {
    XcdBarrier b; b.bar = bar; b.x = xb_xcc_id(); b.st = st;
    if (threadIdx.x == 0) (void)xb_add(&bar[XB_XCNT(b.x)], 1u);
    return b;
}
__device__ __forceinline__ void xcd_barrier_complete(unsigned* bar, unsigned x, unsigned& nloc, unsigned& nx) {
    const unsigned G = gridDim.x * gridDim.y * gridDim.z;
    unsigned sum, cnt, mine, sp = 0u;
    for (;;) {
        sum = 0u; cnt = 0u; mine = 0u;
#pragma unroll
        for (unsigned j = 0; j < 16; ++j) { const unsigned c = xb_ld(&bar[XB_XCNT(j)]); sum += c; cnt += (c > 0u) ? 1u : 0u; mine = (j == x) ? c : mine; }
        if (sum == G) break;
        __builtin_amdgcn_s_sleep(1);
        if ((++sp & 255u) == 0u) { if (xb_ld(&bar[XB_TMO])) break; if (sp > XB_SPIN_CAP) { atomicAdd(&bar[XB_TMO], 1u); break; } }
    }
    nloc = mine > 0u ? mine : 1u; nx = cnt > 0u ? cnt : 1u;
}
__device__ __forceinline__ void xcd_barrier(const XcdBarrier& b) {
    asm volatile("s_waitcnt vmcnt(0)" ::: "memory");
    __syncthreads();
    if (threadIdx.x == 0) {
        unsigned* bar = b.bar;
        __builtin_amdgcn_s_waitcnt(0);
        unsigned nloc = b.st[0], nx = b.st[1];
        if (nloc == 0u) { xcd_barrier_complete(bar, b.x, nloc, nx); b.st[0] = nloc; b.st[1] = nx; }
        const unsigned old = xb_add(&bar[XB_XSUB(b.x)], 1u);
        const unsigned gen = old / nloc;
        if (old + 1u == (gen + 1u) * nloc) {
            __builtin_amdgcn_fence(__ATOMIC_RELEASE, "agent");
            asm volatile("s_waitcnt vmcnt(0)" ::: "memory");
            const unsigned og = xb_add(&bar[XB_TOP], 1u);
            const unsigned tg = og / nx;
            if (og + 1u == (tg + 1u) * nx) xb_add(&bar[XB_TOPGEN], 1u);
            else XB_SPIN(xb_ld(&bar[XB_TOPGEN]) == tg, bar);
            __builtin_amdgcn_fence(__ATOMIC_ACQUIRE, "agent");
            xb_add(&bar[XB_XGEN(b.x)], 1u);
            asm volatile("s_waitcnt vmcnt(0)" ::: "memory");
        } else {
            XB_SPIN(xb_ld(&bar[XB_XGEN(b.x)]) == gen, bar);
            __builtin_amdgcn_fence(__ATOMIC_ACQUIRE, "agent");
            asm volatile("s_waitcnt vmcnt(0)" ::: "memory");
        }
    }
    __syncthreads();
}

struct Frame {
    LAS unsigned char* lds; char* ldsg;
    int tid, lane, wave, vcu, G;
    unsigned char* ws;
    float* out;
};
__device__ __forceinline__ float wave_sum(float v) {
#pragma unroll
    for (int o = 1; o < 64; o <<= 1) v += __shfl_xor(v, o);
    return v;
}
__device__ __forceinline__ void p0_transpose_item(const float* W, int ldw, int K, const float* gain, bf16_t* WT, int nblk, int ncol_src0, int row_off, LAS float* scr, int item, int lane) {
    const int kb = item / nblk, nb = item % nblk, k0 = 64 * kb, n0 = 32 * nb;
#pragma unroll 8
    for (int i = 0; i < 32; ++i) { const int kk = 2 * i + (lane >> 5); float w = W[(size_t)(k0 + kk) * ldw + ncol_src0 + n0 + (lane & 31)]; if (gain) w *= gain[k0 + kk]; scr[kk * 33 + (lane & 31)] = w; }
    LDS_WAIT(); asm volatile("" ::: "memory");
    const int c = lane & 7;
#pragma unroll
    for (int j = 0; j < 4; ++j) { const int n = (lane >> 3) + 8 * j; const LAS float* s = scr + (8 * c) * 33 + n;
        u32x4 o; o.x = cvt_pk_bf16(s[0 * 33], s[1 * 33]); o.y = cvt_pk_bf16(s[2 * 33], s[3 * 33]); o.z = cvt_pk_bf16(s[4 * 33], s[5 * 33]); o.w = cvt_pk_bf16(s[6 * 33], s[7 * 33]);
        *(GAS u32x4*)(WT + (size_t)(row_off + n0 + n) * K + k0 + 8 * c) = o; }
    LDS_WAIT(); asm volatile("" ::: "memory");
}

__device__ __forceinline__ mb::BlockRef moba_ref(const bf16_t* qkvh, bf16_t* omix, const float* kmean, int Li, int pass) {
    mb::BlockRef r; const int bh = Li >> 3, xx = Li & 7, b = bh >> 4, h = bh & 15; const int qb = pass ? 15 - xx : xx;
    const bf16_t* base = qkvh + (size_t)bh * SEQ * 128;
    r.Q = base + (size_t)(qb * 256) * 128; r.K = base + QKVH_T; r.V = base + 2 * QKVH_T; r.O = omix + (size_t)(b * SEQ + qb * 256) * DM + 2048 + h * 128; r.km = kmean + (size_t)bh * 2048; r.qb = qb; return r;
}
__device__ __forceinline__ void p0_transpose64(const float* W, int ldw, int K, const float* gain, bf16_t* WT, int nblk, int ncol_src0, int row_off, LAS float* scr, int item, int lane) {
    const int kb = item / nblk, nb = item % nblk, k0 = 64 * kb, n0 = 64 * nb;
    const int c4 = (lane & 15) * 4, kr = lane >> 4;
    f32x4 w[16];
#pragma unroll
    for (int i = 0; i < 16; ++i) w[i] = __builtin_nontemporal_load((const f32x4*)(W + (size_t)(k0 + kr + 4 * i) * ldw + ncol_src0 + n0 + c4));
#pragma unroll
    for (int i = 0; i < 16; ++i) { f32x4 v = w[i]; if (gain) v = v * gain[k0 + kr + 4 * i]; *(LAS f32x4*)(scr + (kr + 4 * i) * 68 + c4) = v; }
    LDS_WAIT(); asm volatile("" ::: "memory");
#pragma unroll
    for (int j = 0; j < 8; ++j) { const int idx = lane + 64 * j, n = idx >> 3, c = idx & 7; const LAS float* sp = scr + (8 * c) * 68 + n;
        u32x4 o; o.x = cvt_pk_bf16(sp[0 * 68], sp[1 * 68]); o.y = cvt_pk_bf16(sp[2 * 68], sp[3 * 68]); o.z = cvt_pk_bf16(sp[4 * 68], sp[5 * 68]); o.w = cvt_pk_bf16(sp[6 * 68], sp[7 * 68]);
        *(GAS u32x4*)(WT + (size_t)(row_off + n0 + n) * K + k0 + 8 * c) = o; }
    LDS_WAIT(); asm volatile("" ::: "memory");
}
struct P0Item { const float* src; const float* gain; bf16_t* dst; int ldw, K; };
__device__ __forceinline__ P0Item p0_item(const float* W, int ldw, int K, const float* gain, bf16_t* WT, int nblk, int ncol_src0, int row_off, int item) {
    const int kb = item / nblk, nb = item % nblk, k0 = 64 * kb, n0 = 64 * nb; P0Item r;
    r.src = W + (size_t)k0 * ldw + ncol_src0 + n0; r.gain = gain ? gain + k0 : nullptr; r.dst = WT + (size_t)(row_off + n0) * K + k0; r.ldw = ldw; r.K = K; return r; }
__device__ __forceinline__ void p0_load(const P0Item& it, f32x4 (&w)[16], int lane) {
    const unsigned voff = (unsigned)(((lane >> 4) * it.ldw + (lane & 15) * 4) * 4);
#pragma unroll
    for (int i = 0; i < 16; ++i) w[i] = __builtin_nontemporal_load((const f32x4*)((const char*)(it.src + (size_t)(4 * i) * it.ldw) + voff));
}
__device__ __forceinline__ void p0_finish(const P0Item& it, const f32x4 (&w)[16], LAS float* scr, int lane) {
    const int c4 = (lane & 15) * 4, kr = lane >> 4;
    if (it.gain) { const unsigned goff = (unsigned)(kr * 4);
#pragma unroll
        for (int i = 0; i < 16; ++i) { const float g = *(const float*)((const char*)(it.gain + 4 * i) + goff); *(LAS f32x4*)(scr + (kr + 4 * i) * 68 + c4) = w[i] * g; } }
    else {
#pragma unroll
        for (int i = 0; i < 16; ++i) *(LAS f32x4*)(scr + (kr + 4 * i) * 68 + c4) = w[i]; }
    LDS_WAIT(); asm volatile("" ::: "memory");
    const unsigned soff = (unsigned)(((lane >> 3) * it.K + 8 * (lane & 7)) * 2);
#pragma unroll
    for (int j = 0; j < 8; ++j) { const int n = (lane >> 3) + 8 * j, c = lane & 7; const LAS float* sp = scr + (8 * c) * 68 + n;
        u32x4 o; o.x = cvt_pk_bf16(sp[0 * 68], sp[1 * 68]); o.y = cvt_pk_bf16(sp[2 * 68], sp[3 * 68]); o.z = cvt_pk_bf16(sp[4 * 68], sp[5 * 68]); o.w = cvt_pk_bf16(sp[6 * 68], sp[7 * 68]);
        *(GAS u32x4*)((char*)(it.dst + (size_t)(8 * j) * it.K) + soff) = o; }
    LDS_WAIT(); asm volatile("" ::: "memory");
}
template <class F> __device__ __forceinline__ void p0_pipe(int n, F desc, LAS float* scr, int lane) {
    P0Item a = desc(0), b = a; f32x4 w0[16], w1[16];
    p0_load(a, w0, lane);
    for (int j = 0; j < n; j += 2) {
        const bool hb_ = j + 1 < n; if (hb_) { b = desc(j + 1); p0_load(b, w1, lane); }
        p0_finish(a, w0, scr, lane);
        if (!hb_) break;
        if (j + 2 < n) { a = desc(j + 2); p0_load(a, w0, lane); }
        p0_finish(b, w1, scr, lane);
    }
}
__device__ __forceinline__ float absmax8(const u32x4 (&w)[8]) { float mx = 0.f;
#pragma unroll
    for (int j = 0; j < 8; ++j) mx = fmaxf(mx, fmaxf(fmaxf(fmaxf(fabsf(bflo(w[j].x)), fabsf(bfhi(w[j].x))), fmaxf(fabsf(bflo(w[j].y)), fabsf(bfhi(w[j].y)))), fmaxf(fmaxf(fabsf(bflo(w[j].z)), fabsf(bfhi(w[j].z))), fmaxf(fabsf(bflo(w[j].w)), fabsf(bfhi(w[j].w))))));
#pragma unroll
    for (int o = 1; o < 64; o <<= 1) mx = fmaxf(mx, __shfl_xor(mx, o));
    return mx; }
__device__ __forceinline__ void quant_store8(const u32x4 (&w)[8], float inv, signed char* dst, int lane) { u32x2* qp = (u32x2*)dst + lane;
#pragma unroll
    for (int j = 0; j < 8; ++j) { const unsigned ww[4] = {w[j].x, w[j].y, w[j].z, w[j].w}; unsigned o2[2];
#pragma unroll
        for (int h2 = 0; h2 < 2; ++h2) { const int q0 = (int)rintf(bflo(ww[2 * h2]) * inv), q1 = (int)rintf(bfhi(ww[2 * h2]) * inv), q2 = (int)rintf(bflo(ww[2 * h2 + 1]) * inv), q3 = (int)rintf(bfhi(ww[2 * h2 + 1]) * inv);
            o2[h2] = (unsigned)(q0 & 255) | ((unsigned)(q1 & 255) << 8) | ((unsigned)(q2 & 255) << 16) | ((unsigned)(q3 & 255) << 24); }
        u32x2 o; o.x = o2[0]; o.y = o2[1]; qp[64 * j] = o; } }
__device__ __forceinline__ void quant_rows2(const bf16_t* s0, const bf16_t* s1, signed char* d0, signed char* d1, int lane, float& step0, float& step1) {
    const u32x4* p0 = (const u32x4*)s0 + lane; const u32x4* p1 = (const u32x4*)s1 + lane; u32x4 w0[8], w1[8];
#pragma unroll
    for (int j = 0; j < 8; ++j) { w0[j] = p0[64 * j]; w1[j] = p1[64 * j]; }
    step0 = fmaxf(absmax8(w0), 1e-30f) * (1.0f / 127.0f); step1 = fmaxf(absmax8(w1), 1e-30f) * (1.0f / 127.0f);
    quant_store8(w0, 1.0f / step0, d0, lane); quant_store8(w1, 1.0f / step1, d1, lane);
}
__device__ __forceinline__ void rot_load(u32x4 (&w)[8], const bf16_t* src, int tl) {
#pragma unroll
    for (int j = 0; j < 8; ++j) w[j] = __builtin_nontemporal_load((const u32x4*)src + j * 256 + tl);
}
template <bool CENTER>
__device__ __forceinline__ void rot_finish(const u32x4 (&w)[8], signed char* dst, LAS float* red, int tl, int half, int wv4, int lane, float& step_out, float& sum_out) {
    f32x2 pr[32];
#pragma unroll
    for (int j = 0; j < 8; ++j) { pr[4 * j] = (f32x2){bflo(w[j].x), bfhi(w[j].x)}; pr[4 * j + 1] = (f32x2){bflo(w[j].y), bfhi(w[j].y)}; pr[4 * j + 2] = (f32x2){bflo(w[j].z), bfhi(w[j].z)}; pr[4 * j + 3] = (f32x2){bflo(w[j].w), bfhi(w[j].w)}; }
#pragma unroll
    for (int i = 0; i < 32; ++i) { const float a = pr[i][0], b = pr[i][1]; pr[i] = (f32x2){a + b, a - b}; }
#pragma unroll
    for (int h = 1; h < 32; h <<= 1)
#pragma unroll
        for (int i = 0; i < 32; ++i) if (!(i & h)) { const f32x2 a = pr[i], b = pr[i + h]; pr[i] = a + b; pr[i + h] = a - b; }
    float sm = pr[0][0];
#pragma unroll
    for (int o = 1; o < 64; o <<= 1) sm += __shfl_xor(sm, o);
    float mx = 0.f;
    if (CENTER) {
        if (lane == 0) red[half * 4 + wv4] = sm;
        __syncthreads();
        sm = (red[half * 4] + red[half * 4 + 1]) + (red[half * 4 + 2] + red[half * 4 + 3]);
        pr[0][0] -= sm * (64.0f / DFF);
    }
#pragma unroll
    for (int i = 0; i < 32; ++i) mx = fmaxf(mx, fmaxf(fabsf(pr[i][0]), fabsf(pr[i][1])));
#pragma unroll
    for (int o = 1; o < 64; o <<= 1) mx = fmaxf(mx, __shfl_xor(mx, o));
    if (lane == 0) { red[16 + half * 4 + wv4] = mx; if (!CENTER) red[half * 4 + wv4] = sm; }
    __syncthreads();
    mx = fmaxf(fmaxf(red[16 + half * 4], red[16 + half * 4 + 1]), fmaxf(red[16 + half * 4 + 2], red[16 + half * 4 + 3]));
    if (!CENTER) sm = (red[half * 4] + red[half * 4 + 1]) + (red[half * 4 + 2] + red[half * 4 + 3]);
    const float step = fmaxf(mx, 1e-30f) * (1.0f / 127.0f), inv = 1.0f / step;
#pragma unroll
    for (int jj = 0; jj < 4; ++jj) { unsigned o4[4];
#pragma unroll
        for (int d = 0; d < 4; ++d) { const f32x2 a = pr[8 * jj + 2 * d] * inv, b = pr[8 * jj + 2 * d + 1] * inv;
            const int q0 = (int)rintf(a[0]), q1 = (int)rintf(a[1]), q2 = (int)rintf(b[0]), q3 = (int)rintf(b[1]);
            o4[d] = (unsigned)(q0 & 255) | ((unsigned)(q1 & 255) << 8) | ((unsigned)(q2 & 255) << 16) | ((unsigned)(q3 & 255) << 24); }
        u32x4 o; o.x = o4[0]; o.y = o4[1]; o.z = o4[2]; o.w = o4[3]; *((u32x4*)dst + jj * 256 + tl) = o; }
    step_out = step; sum_out = sm;
    __syncthreads();
}
template <bool CENTER, class Fin>
__device__ __forceinline__ void rot_rows(const bf16_t* src, size_t src_ld, signed char* dst, int row0, int n, LAS float* red, int tl, int half, int wv4, int lane, Fin fin) {
    u32x4 wa[8], wb[8]; float st, sm;
    rot_load(wa, src + (size_t)(row0 + half) * src_ld, tl);
    for (int it = 0; it < n; it += 2) {
        const int ra = row0 + 2 * it + half, rb = ra + 2;
        rot_load(wb, src + (size_t)rb * src_ld, tl);
        rot_finish<CENTER>(wa, dst + (size_t)ra * RQ_LD, red, tl, half, wv4, lane, st, sm); if (tl == 0) fin(ra, st, sm);
        if (it + 2 < n) rot_load(wa, src + (size_t)(rb + 2) * src_ld, tl);
        rot_finish<CENTER>(wb, dst + (size_t)rb * RQ_LD, red, tl, half, wv4, lane, st, sm); if (tl == 0) fin(rb, st, sm);
    }
}
struct Args { const float* in[18]; float* out; unsigned char* ws; int ph_lo, ph_hi; };
__global__ void __launch_bounds__(NWAVES * 64, 2) fwd(Args args) {
    extern __shared__ __attribute__((aligned(16))) unsigned char lds[];
    Frame F;
    F.lds = (LAS unsigned char*)lds; F.ldsg = (char*)lds;
    F.tid = threadIdx.x; F.lane = F.tid & 63; F.wave = __builtin_amdgcn_readfirstlane(F.tid >> 6);
    F.G = gridDim.x; { const int bx = blockIdx.x; F.vcu = (F.G % 8 == 0) ? (bx % 8) * (F.G / 8) + bx / 8 : bx; }
    F.ws = args.ws; F.out = args.out;
    unsigned char* ws = args.ws;
    volatile LAS unsigned* MISC = (volatile LAS unsigned*)(F.lds + MISC_OFF);
    for (int u = F.tid; u < (LDS_BYTES - LDSCTL_OFF) / 4; u += NWAVES * 64) ((LAS unsigned*)(F.lds + LDSCTL_OFF))[u] = 0u;
    __syncthreads();
    XcdBarrier bar; bar.bar = (unsigned*)(ws + WS_CTL) + CW_BAR; bar.x = 0; bar.st = nullptr;
    if (MK_ONE_LAUNCH) bar = xcd_barrier_post((unsigned*)(ws + WS_CTL) + CW_BAR, MISC + 8);
    const int lo = args.ph_lo, hi = args.ph_hi;
#ifndef PH_MASK
#define PH_MASK 0xFFFF
#endif
#define IN(k) (((PH_MASK >> (k)) & 1) && lo <= (k) && (k) < hi)
#define SEAM(k) do { if (IN(k) && IN((k) + 1)) xcd_barrier(bar); } while (0)

#define ARGP(k) (((const float* const volatile*)((const Args*)__builtin_amdgcn_kernarg_segment_ptr())->in)[k])
#define in_x ARGP(0)
#define in_mem ARGP(1)
#define g_mix ARGP(2)
#define w_in ARGP(3)
#define w_gate_up ARGP(4)
#define b_gate ARGP(5)
#define gla_norm_g ARGP(6)
#define w_out ARGP(7)
#define g_cross ARGP(8)
#define g_mem ARGP(9)
#define w_cq ARGP(10)
#define w_ck ARGP(11)
#define w_cv ARGP(12)
#define w_co ARGP(13)
#define g_mlp ARGP(14)
#define w_up ARGP(15)
#define w_down ARGP(16)
#define g_final ARGP(17)
    float* rstd_x = (float*)(ws + WS_RSTDX); float* colq = (float*)(ws + WS_RSTD1); float* rowq = (float*)(ws + WS_RSTD2);
    signed char* W_upq = (signed char*)F.out + 128 * MiB; signed char* hq = (signed char*)F.out + 192 * MiB;
    float* colq_up = (float*)(ws + WS_WGLOW + 262144); float* rowq2 = (float*)(ws + WS_WGLOW + 393216);
    signed char* uq = (signed char*)(ws + WS_UQ); signed char* Wdq = (signed char*)(ws + WS_WDQ);
    float* sw_dn = (float*)(ws + WS_WGLOW + 524288); float* cw_dn = sw_dn + 4096; float* sa_u = cw_dn + 4096; float* m_u = sa_u + T;
    signed char* xq = (signed char*)(ws + WS_OMIX); signed char* W_inq = (signed char*)(ws + WS_OMIX + 64 * MiB);
    float* ropec = (float*)(ws + WS_ROPEC); float* ropes = (float*)(ws + WS_ROPES); float* kmean = (float*)(ws + WS_KMEAN);
    float* glow = (float*)(ws + WS_GLOW); float* part = (float*)(ws + WS_PART);
    bf16_t* W_inT = (bf16_t*)(ws + WS_WIN); bf16_t* W_outT = (bf16_t*)(ws + WS_WOUT); bf16_t* W_ckvT = (bf16_t*)(ws + WS_WCKV); bf16_t* W_cqb = (bf16_t*)(ws + WS_WCQ);
    bf16_t* W_coT = (bf16_t*)(ws + WS_WCO); bf16_t* W_upT = (bf16_t*)(ws + WS_WUP); bf16_t* W_dnT = (bf16_t*)(ws + WS_WDN);
    bf16_t* WqkT = (bf16_t*)(ws + WS_WQK); bf16_t* WvoT = (bf16_t*)(ws + WS_WVO); bf16_t* kcvc = (bf16_t*)(ws + WS_KCVC); bf16_t* memn = (bf16_t*)(ws + WS_MEMN);
    bf16_t* hb = (bf16_t*)(ws + WS_HB); bf16_t* proj = (bf16_t*)(ws + WS_PROJ); bf16_t* qkvh = (bf16_t*)(ws + WS_QKVH); bf16_t* omix = (bf16_t*)(ws + WS_OMIX); bf16_t* Pm = (bf16_t*)(ws + WS_P); bf16_t* Ub = (bf16_t*)(ws + WS_U);
    bf16_t* dSt = (bf16_t*)F.out;
    float* decay = (float*)(ws + WS_DECAY); bf16_t* W_glowT = (bf16_t*)(ws + WS_WGLOW);
    const int gw = F.vcu * NWAVES + F.wave, NGW = F.G * NWAVES;

    constexpr int NQB = (IN_N - IN_Q0) / 64;
    static_assert(NQB <= 200, "P0 needs some workgroups without an int8 in-projection block");
    if (IN(0)) {
        LAS float* scr = (LAS float*)(F.lds + F.wave * 17408);
        const int bx = (int)blockIdx.x;
        if (bx < NQB) {
            const int nb = IN_Q0 / 64 + bx, src0 = (nb * 64 >= 4096) ? 16 : 0;
            { const float* wsrc = w_in; const float* gsrc = g_mix; const int wv = F.wave;
              p0_pipe(8, [&](int i) { return p0_item(wsrc, INW, DM, gsrc, W_inT, IN_N / 64, src0, 0, (wv + 8 * i) * (IN_N / 64) + nb); }, scr, F.lane); }
            VM_WAIT(); __syncthreads();
            for (int p = 0; p < 4; ++p) { const int n = 64 * bx + 8 * F.wave + 2 * p; float s0, s1;
                const int na = n < 4096 ? (n & ~127) + pg8::EpiProjMoba::qk_pos(n & 127) : n, nb = n < 4096 ? (n & ~127) + pg8::EpiProjMoba::qk_pos((n + 1) & 127) : n + 1;
                quant_rows2(W_inT + (size_t)(IN_Q0 + n) * DM, W_inT + (size_t)(IN_Q0 + n + 1) * DM, W_inq + (size_t)na * DM, W_inq + (size_t)nb * DM, F.lane, s0, s1);
                if (F.lane == 0) { colq[na] = s0; colq[nb] = s1; } }
        } else {
            constexpr int I_INL = (DM / 64) * (IN_Q0 / 64);
            for (int it = (bx - NQB) * NWAVES + F.wave; it < I_INL; it += (256 - NQB) * NWAVES) { const int kb = it / (IN_Q0 / 64), nb = it % (IN_Q0 / 64);
                p0_transpose64(w_in, INW, DM, g_mix, W_inT, IN_N / 64, (nb * 64 >= 4096) ? 16 : 0, 0, scr, kb * (IN_N / 64) + nb, F.lane); }
        }
        { int m, mstep, mcnt;
          if (bx < NQB) { m = bx * 48 + F.wave * 6; mstep = 1; mcnt = 6; } else { m = NQB * 48 + (bx - NQB) * NWAVES + F.wave; mstep = (256 - NQB) * NWAVES; mcnt = T; }
          for (int j = 0; j < mcnt && m < T; ++j, m += mstep) {
            const f32x4* xr = (const f32x4*)(in_x + (size_t)m * DM) + F.lane; f32x4 v[16]; float s2 = 0.f;
#pragma unroll
            for (int j2 = 0; j2 < 16; ++j2) { v[j2] = __builtin_nontemporal_load(xr + 64 * j2); s2 += (v[j2][0] * v[j2][0] + v[j2][1] * v[j2][1]) + (v[j2][2] * v[j2][2] + v[j2][3] * v[j2][3]); }
            const float rs = 1.0f / sqrtf(wave_sum(s2) * (1.0f / DM) + EPS);
            float mx = 0.f;
#pragma unroll
            for (int j2 = 0; j2 < 16; ++j2) mx = fmaxf(fmaxf(mx, fmaxf(fabsf(v[j2][0]), fabsf(v[j2][1]))), fmaxf(fabsf(v[j2][2]), fabsf(v[j2][3])));
#pragma unroll
            for (int o = 1; o < 64; o <<= 1) mx = fmaxf(mx, __shfl_xor(mx, o));
            const float step = fmaxf(mx, 1e-30f) * (1.0f / 127.0f), inv = 1.0f / step;
            if (F.lane == 0) { rstd_x[m] = rs; rowq[m] = rs * step; }
            u32x2* o8 = (u32x2*)(hb + (size_t)m * DM) + F.lane; unsigned* q4 = (unsigned*)(xq + (size_t)m * DM) + F.lane;
#pragma unroll
            for (int j2 = 0; j2 < 16; ++j2) { u32x2 w; w.x = cvt_pk_bf16(v[j2][0], v[j2][1]); w.y = cvt_pk_bf16(v[j2][2], v[j2][3]); o8[64 * j2] = w;
                const int q0 = (int)rintf(v[j2][0] * inv), q1 = (int)rintf(v[j2][1] * inv), q2 = (int)rintf(v[j2][2] * inv), q3 = (int)rintf(v[j2][3] * inv);
                q4[64 * j2] = (unsigned)(q0 & 255) | ((unsigned)(q1 & 255) << 8) | ((unsigned)(q2 & 255) << 16) | ((unsigned)(q3 & 255) << 24); }
          } }
        for (int m = gw; m < TM; m += NGW) {
            const f32x4* xr = (const f32x4*)(in_mem + (size_t)m * DM) + F.lane; f32x4 v[16]; float s2 = 0.f;
#pragma unroll
            for (int j = 0; j < 16; ++j) { v[j] = xr[64 * j]; s2 += (v[j][0] * v[j][0] + v[j][1] * v[j][1]) + (v[j][2] * v[j][2] + v[j][3] * v[j][3]); }
            const float rs = 1.0f / sqrtf(wave_sum(s2) * (1.0f / DM) + EPS);
            u32x2* o8 = (u32x2*)(memn + (size_t)m * DM) + F.lane;
#pragma unroll
            for (int j = 0; j < 16; ++j) { const f32x4 g = *((const f32x4*)g_mem + F.lane + 64 * j); u32x2 w; w.x = cvt_pk_bf16(v[j][0] * rs * g[0], v[j][1] * rs * g[1]); w.y = cvt_pk_bf16(v[j][2] * rs * g[2], v[j][3] * rs * g[3]); o8[64 * j] = w; }
        }
        for (int e = gw * 64 + F.lane; e < SEQ * 16; e += NGW * 64) { const int pos = e >> 4, i = e & 15;
            const float inv_freq = powf(500000.0f, -(float)i * (1.0f / 16.0f)); const float ang = (float)pos * inv_freq;
            ropec[e] = cosf(ang); ropes[e] = sinf(ang);
            const int n = e >> 12, kk = e & 4095; W_glowT[e] = gla::f2bf1(w_in[(size_t)kk * INW + 4096 + n] * g_mix[kk]); }
    }
    SEAM(0);

    if (IN(2)) {
        const int slot = ((int)blockIdx.x & 63) % 3;
#define P2_SLICE() do {                                                                                                                                                             \
        int ln_ = F.lane, wv_ = F.wave, bx_ = (int)blockIdx.x; asm volatile("" : "+v"(ln_)); asm volatile("" : "+s"(wv_)); asm volatile("" : "+s"(bx_));     \
        const int ln = ln_, wv = wv_, bx = bx_; LAS float* scr = (LAS float*)(F.lds + wv * 17408);                                                                                      \
                                                                                           \
        { const float* wsrc = w_up; const float* gsrc = g_mlp;                                                                                               \
          p0_pipe(8, [&](int i) { return p0_item(wsrc, DFF, DM, gsrc, W_upT, DFF / 64, 0, 0, (wv + 8 * i) * (DFF / 64) + bx); }, scr, ln); }                                     \
        VM_WAIT(); __syncthreads();                                                                                                                                                 \
        for (int p = 0; p < 4; ++p) { const int n = 64 * bx + 8 * wv + 2 * p; float s0, s1;                                                                                     \
            quant_rows2(W_upT + (size_t)n * DM, W_upT + (size_t)(n + 1) * DM, W_upq + (size_t)n * DM, W_upq + (size_t)(n + 1) * DM, ln, s0, s1);                                \
            if (ln == 0) { colq_up[n] = s0; colq_up[n + 1] = s1; } }                                                                                                            \
                                         \
        { constexpr int I_SQ = (DM / 64) * (DM / 64), I_DN = (DFF / 64) * (DM / 64); static_assert(4 * I_SQ + I_DN == 256 * 128, "generic weight items");                            \
          const float* s_out = w_out; const float* s_ck = w_ck; const float* s_cv = w_cv; const float* s_co = w_co; const float* s_dn = w_down; const int it0 = bx * 128 + wv;   \
          p0_pipe(16, [&](int i) { int r = it0 + 8 * i;                                                                                                                             \
              if (r < I_SQ) return p0_item(s_out, DM, DM, nullptr, W_outT, DM / 64, 0, 0, r); r -= I_SQ;                                                                            \
              if (r < I_SQ) return p0_item(s_ck, DM, DM, nullptr, W_ckvT, DM / 64, 0, 0, r); r -= I_SQ;                                                                             \
              if (r < I_SQ) return p0_item(s_cv, DM, DM, nullptr, W_ckvT, DM / 64, 0, DM, r); r -= I_SQ;                                                                            \
              if (r < I_SQ) return p0_item(s_co, DM, DM, nullptr, W_coT, DM / 64, 0, 0, r); r -= I_SQ;                                                                              \
              return p0_item(s_dn, DM, DFF, nullptr, W_dnT, DM / 64, 0, 0, r); }, scr, ln);                                                                                     \
          for (int q = 0; q < 2; ++q) {                                                                                      \
              const int kk = bx * 16 + wv * 2 + q; const float g = g_cross[kk]; const f32x4* src = (const f32x4*)(w_cq + (size_t)kk * DM) + ln; u32x2* dst = (u32x2*)(W_cqb + (size_t)kk * DM) + ln;   \
              _Pragma("unroll") for (int j = 0; j < 16; ++j) { const f32x4 v = __builtin_nontemporal_load(src + 64 * j); u32x2 w; w.x = cvt_pk_bf16(v[0] * g, v[1] * g); w.y = cvt_pk_bf16(v[2] * g, v[3] * g); dst[64 * j] = w; } } }   \
                                                               \
        { const int it = F.vcu * NWAVES + wv, grp = it >> 1, kh = it & 1, i = ln & 15, kq = ln >> 4;                                                                    \
            const bf16_t* ap = hb + (size_t)(grp * 16 + i) * DM + kh * 2048 + kq * 8; const bf16_t* bp = W_glowT + (size_t)i * DM + kh * 2048 + kq * 8;                             \
            f32x4 acc = {0.f, 0.f, 0.f, 0.f};                                                                                                                                       \
            _Pragma("unroll 8") for (int k0 = 0; k0 < 2048; k0 += 32) acc = __builtin_amdgcn_mfma_f32_16x16x32_bf16(*(const bf16x8*)(ap + k0), *(const bf16x8*)(bp + k0), acc, 0, 0, 0);   \
            __syncthreads();                                                                                                                                                        \
            LAS f32x4* xch = (LAS f32x4*)F.lds + (wv >> 1) * 64 + ln;                                                                                                       \
            if (kh == 1) *xch = acc;                                                                                                                                                \
            __syncthreads();                                                                                                                                                        \
            if (kh == 0) { acc = acc + *xch;                                                                                                                                        \
                _Pragma("unroll") for (int r = 0; r < 4; ++r) { const int row = grp * 16 + 4 * kq + r; glow[(size_t)row * 16 + i] = acc[r] * rstd_x[row]; } } }                     \
        VM_WAIT(); __syncthreads(); } while (0)
        if (slot == 0) P2_SLICE();
        { pg8::StdPtrs P{(const char*)hb, (const char*)W_inT, DM, DM, DM, 0, 0}; pg8::StaticOrder S; S.init(T, IN_Q0, F.G, (int)blockIdx.x);
          pg8::EpiBf16<0> E{proj, PROJ_LD, rstd_x};
          pg8::gemm_phase<pg8::EpiBf16<0>, pg8::StaticOrder, pg8::StdPtrs, true>(F.lds, P, S, E); }
        if (slot == 1) P2_SLICE();
        { pg8::StdPtrs P{(const char*)xq, (const char*)W_inq, DM / 2, DM / 2, DM / 2, 0, 0}; pg8::StaticOrder S; S.init(T, IN_N - IN_Q0, F.G, (int)blockIdx.x);
          pg8::EpiProjMoba E{proj, qkvh, rowq, colq, ropec, ropes, IN_Q0 / 256};
          pg8::gemm_phase<pg8::EpiProjMoba, pg8::StaticOrder, pg8::StdPtrs, true, true>(F.lds, P, S, E); }
        if (slot == 2) P2_SLICE();
#undef P2_SLICE
    }
    SEAM(2);

    if (IN(3)) {
        for (int it = gw; it < 64 * 16; it += NGW) {
            const int bh = it >> 4, blk = it & 15, b = bh >> 4, h = bh & 15, rsub = F.lane >> 4, c8 = (F.lane & 15) * 8;
            const bf16_t* kp = qkvh + QKVH_T + ((size_t)bh * SEQ + blk * 256 + rsub) * 128 + c8; float a[8];
#pragma unroll
            for (int j = 0; j < 8; ++j) a[j] = 0.f;
#pragma unroll 16
            for (int r = 0; r < 64; ++r) { const u32x4 w = *(const u32x4*)(kp + (size_t)(4 * r) * 128);
                a[0] += bflo(w.x); a[1] += bfhi(w.x); a[2] += bflo(w.y); a[3] += bfhi(w.y); a[4] += bflo(w.z); a[5] += bfhi(w.z); a[6] += bflo(w.w); a[7] += bfhi(w.w); }
#pragma unroll
            for (int j = 0; j < 8; ++j) { a[j] += __shfl_xor(a[j], 16); a[j] += __shfl_xor(a[j], 32); a[j] *= (1.0f / 256.0f); }
            if (rsub == 0) { float* o = kmean + (size_t)it * 128 + c8; *(f32x4*)o = (f32x4){a[0], a[1], a[2], a[3]}; *(f32x4*)(o + 4) = (f32x4){a[4], a[5], a[6], a[7]}; }
        }
        VM_WAIT(); __syncthreads();
        { pg8::StdPtrs P{(const char*)memn, (const char*)W_ckvT, DM, DM, DM, 0, 0}; pg8::StaticOrder S; S.init(TM, 2 * DM, F.G, (int)blockIdx.x);
          pg8::EpiBf16<0> E{kcvc, 2 * DM, nullptr};
          pg8::gemm_phase<pg8::EpiBf16<0>, pg8::StaticOrder, pg8::StdPtrs, true>(F.lds, P, S, E); }
        { const int bx = (int)blockIdx.x; int u0, nu;
          if (bx < 128) { u0 = bx * 4; nu = 4; } else { u0 = 512 + (bx - 128) * 12; nu = 12; }
          for (int j = 0; j < nu; ++j) gla::ga_unit(F.lds, u0 + j, proj, glow, w_gate_up, b_gate, dSt, decay, F.tid, F.wave, F.lane); }
    }
    SEAM(3);

    if (IN(4)) {
        for (int e = (F.vcu * NWAVES * 64) + F.tid; e < 32 * 256 * 16; e += F.G * NWAVES * 64) {
            const int bh = e >> 12, rem = e & 4095, v = rem >> 4, kg = rem & 15;
            u32x4* p = (u32x4*)(dSt + ((size_t)(bh * 64) * 256 + v) * 128 + kg * 8);
            const f32x4* dp = (const f32x4*)(decay + (size_t)bh * 64 * 128 + kg * 8);
            float st[8];
#pragma unroll
            for (int j = 0; j < 8; ++j) st[j] = 0.f;
#pragma unroll 8
            for (int n = 0; n < 64; ++n) { const u32x4 w = p[(size_t)n * 4096]; const f32x4 d0 = dp[n * 32], d1 = dp[n * 32 + 1];
                u32x4 o; o.x = cvt_pk_bf16(st[0], st[1]); o.y = cvt_pk_bf16(st[2], st[3]); o.z = cvt_pk_bf16(st[4], st[5]); o.w = cvt_pk_bf16(st[6], st[7]); p[(size_t)n * 4096] = o;
                st[0] = st[0] * d0[0] + bflo(w.x); st[1] = st[1] * d0[1] + bfhi(w.x); st[2] = st[2] * d0[2] + bflo(w.y); st[3] = st[3] * d0[3] + bfhi(w.y);
                st[4] = st[4] * d1[0] + bflo(w.z); st[5] = st[5] * d1[1] + bfhi(w.z); st[6] = st[6] * d1[2] + bflo(w.w); st[7] = st[7] * d1[3] + bfhi(w.w); }
        }
        __syncthreads();
        { pg8::QkVoPtrs P{(const char*)kcvc, (const char*)W_cqb, (const char*)W_coT, 1024, 0, 0};
          pg8::QkVoPtrs Pq = P; Pq.lda = 2 * DM; Pq.ldb = DM; pg8::LinearOrder Sq{256, F.G, F.vcu, 0};
          pg8::EpiQkVo E{WqkT, WvoT};
          pg8::gemm_phase<pg8::EpiQkVo, pg8::LinearOrder, pg8::QkVoPtrs, true>(F.lds, Pq, Sq, E);
          pg8::QkVoPtrs Pv = P; Pv.lda = DM; Pv.ldb = 2 * DM;
          pg8::LinearOrder Sv{256, F.G, F.vcu, 256};
          pg8::gemm_phase<pg8::EpiQkVo, pg8::LinearOrder, pg8::QkVoPtrs, true>(F.lds, Pv, Sv, E); }
        {
            char* al = F.ldsg;
            const int total = 64 * 8;
            int L = F.vcu;
            if (L < total) {
                int pass = 0; mb::BlockRef cur = moba_ref(qkvh, omix, kmean, L, 0); mb::Seam S;
                mb::moba_prime(cur, al, S);
                for (;;) {
                    const bool more_pass = pass == 0, more_item = L + F.G < total, last = !more_pass && !more_item;
                    int passn = pass + 1, Ln = L; if (!more_pass) { passn = 0; Ln = more_item ? L + F.G : L; }
                    const mb::BlockRef nxt = last ? cur : moba_ref(qkvh, omix, kmean, Ln, passn);
                    mb::moba_block(cur, nxt, al, S);
                    if (last) break;
                    cur = nxt; pass = passn; L = Ln;
                }
            }
            VM_WAIT(); __syncthreads();
        }
    }
    SEAM(4);

    if (IN(5)) {
        for (int un = F.vcu; un < 2048; un += F.G) gla::gc_unit(F.lds, un, proj, dSt, gla_norm_g, omix, F.tid, F.wave, F.lane);
    }
    SEAM(5);

    if (IN(6)) {
        pg8::StdPtrs P{(const char*)omix, (const char*)W_outT, DM, DM, DM, 0, 0}; pg8::StaticOrder S; S.init(T, DM, F.G, (int)blockIdx.x);
        pg8::EpiResid<false> E{(const void*)hb, hb, part};
        pg8::gemm_phase<pg8::EpiResid<false>, pg8::StaticOrder, pg8::StdPtrs, true>(F.lds, P, S, E);
    }
    SEAM(6);
    if (IN(7)) {
        pg8::StdPtrs P{(const char*)hb, (const char*)WqkT, DM, DM, DM, 16, (size_t)1024 * DM * 2}; pg8::StaticOrder S; S.init(T, 1024, F.G, (int)blockIdx.x);
        pg8::EpiSoftmax E{Pm, part};
        pg8::gemm_phase<pg8::EpiSoftmax, pg8::StaticOrder, pg8::StdPtrs, false>(F.lds, P, S, E);
    }
    SEAM(7);
    if (IN(8)) {
        pg8::StdPtrs P{(const char*)Pm, (const char*)WvoT, 1024, 1024, 1024, 16, (size_t)DM * 1024 * 2}; pg8::StaticOrder S; S.init(T, DM, F.G, (int)blockIdx.x);
        pg8::EpiResid<false> E{(const void*)hb, hb, part};
        pg8::gemm_phase<pg8::EpiResid<false>, pg8::StaticOrder, pg8::StdPtrs, true>(F.lds, P, S, E);
    }
    SEAM(8);
    if (IN(9)) {
        for (int row = gw; row < T; row += 2 * NGW) { const int row2 = row + NGW;
            const float pa = part[(size_t)row * 64 + F.lane], pb = part[(size_t)row2 * 64 + F.lane];
            float st0, st1; quant_rows2(hb + (size_t)row * DM, hb + (size_t)row2 * DM, hq + (size_t)row * DM, hq + (size_t)row2 * DM, F.lane, st0, st1);
            const float rsa = 1.0f / sqrtf(wave_sum(pa) * (1.0f / DM) + EPS), rsb = 1.0f / sqrtf(wave_sum(pb) * (1.0f / DM) + EPS);
            if (F.lane == 0) { rowq2[row] = rsa * st0; rowq2[row2] = rsb * st1; }
        }
        { LAS float* red = (LAS float*)F.lds; const int half = F.wave >> 2, wv4 = F.wave & 3, tl = F.tid & 255;
          rot_rows<false>(W_dnT, (size_t)DFF, Wdq, (int)blockIdx.x * 16, 8, red, tl, half, wv4, F.lane, [&](int n, float st, float sm) { sw_dn[n] = st * (1.0f / 64.0f); cw_dn[n] = sm; }); }
    }
    SEAM(9);
    if (IN(10)) {
        pg8::StdPtrs P{(const char*)hq, (const char*)W_upq, DM / 2, DM / 2, DM / 2, 0, 0}; pg8::StaticOrder S; S.init(T, DFF, F.G, (int)blockIdx.x);
        pg8::EpiUpI8 E{Ub, U_LD, rowq2, colq_up};
        pg8::gemm_phase<pg8::EpiUpI8, pg8::StaticOrder, pg8::StdPtrs, true, true>(F.lds, P, S, E);
    }
    SEAM(10);
    if (IN(11)) {
        LAS float* red = (LAS float*)F.lds; const int half = F.wave >> 2, wv4 = F.wave & 3, tl = F.tid & 255;
        rot_rows<true>(Ub, (size_t)U_LD, uq, (int)blockIdx.x * 64, 32, red, tl, half, wv4, F.lane, [&](int row, float st, float sm) { sa_u[row] = st; m_u[row] = sm * (1.0f / DFF); });
    }
    SEAM(11);
    if (IN(12)) {
        pg8::StdPtrs P{(const char*)uq, (const char*)Wdq, DFF / 2, RQ_LD / 2, RQ_LD / 2, 0, 0}; pg8::StaticOrder S; S.init(T, DM, F.G, (int)blockIdx.x);
        pg8::EpiResidI8 E{hb, hb, part, sa_u, m_u, sw_dn, cw_dn};
        pg8::gemm_phase<pg8::EpiResidI8, pg8::StaticOrder, pg8::StdPtrs, true, true>(F.lds, P, S, E);
    }
    SEAM(12);
    if (IN(13)) {
        const f32x4* gfp = (const f32x4*)g_final + 2 * F.lane;
        for (int row = gw; row < T; row += 2 * NGW) {
            const int row2 = row + NGW;
            const float pa = part[(size_t)row * 64 + F.lane], pb = part[(size_t)row2 * 64 + F.lane];
            const u32x4* hp = (const u32x4*)(hb + (size_t)row * DM) + F.lane; const u32x4* hq = (const u32x4*)(hb + (size_t)row2 * DM) + F.lane; u32x4 wa[8], wb[8];
#pragma unroll
            for (int j = 0; j < 8; ++j) { wa[j] = hp[64 * j]; wb[j] = hq[64 * j]; }
            const float rsa = 1.0f / sqrtf(wave_sum(pa) * (1.0f / DM) + EPS), rsb = 1.0f / sqrtf(wave_sum(pb) * (1.0f / DM) + EPS);
            f32x4* oa = (f32x4*)(F.out + (size_t)row * DM) + 2 * F.lane; f32x4* ob = (f32x4*)(F.out + (size_t)row2 * DM) + 2 * F.lane;
#pragma unroll
            for (int j = 0; j < 8; ++j) { const f32x4 g0 = gfp[128 * j], g1 = gfp[128 * j + 1]; const u32x4 w = wa[j], w2 = wb[j];
                const f32x4 v0 = {bflo(w.x) * g0[0] * rsa, bfhi(w.x) * g0[1] * rsa, bflo(w.y) * g0[2] * rsa, bfhi(w.y) * g0[3] * rsa}, v1 = {bflo(w.z) * g1[0] * rsa, bfhi(w.z) * g1[1] * rsa, bflo(w.w) * g1[2] * rsa, bfhi(w.w) * g1[3] * rsa};
                const f32x4 u0 = {bflo(w2.x) * g0[0] * rsb, bfhi(w2.x) * g0[1] * rsb, bflo(w2.y) * g0[2] * rsb, bfhi(w2.y) * g0[3] * rsb}, u1 = {bflo(w2.z) * g1[0] * rsb, bfhi(w2.z) * g1[1] * rsb, bflo(w2.w) * g1[2] * rsb, bfhi(w2.w) * g1[3] * rsb};
                __builtin_nontemporal_store(v0, oa + 128 * j); __builtin_nontemporal_store(v1, oa + 128 * j + 1); __builtin_nontemporal_store(u0, ob + 128 * j); __builtin_nontemporal_store(u1, ob + 128 * j + 1); } }
    }
#undef IN
#undef SEAM
}

extern "C" void kernel_launch(void* const* d_in, const int* in_sizes, int n_in, void* d_out, int out_size, void* d_ws, size_t ws_size, hipStream_t stream) {
    static int grid = 0;
    if (grid == 0) {
        if (n_in != 18 || in_sizes[0] != T * DM || out_size != T * DM || ws_size < WS_END) { fprintf(stderr, "kernel_launch: unexpected shapes / workspace (n_in %d, ws %zu < %zu)\n", n_in, ws_size, (size_t)WS_END); grid = -1; return; }
        int dev = 0, cus = 0;
        if (hipGetDevice(&dev) != hipSuccess || hipDeviceGetAttribute(&cus, hipDeviceAttributeMultiprocessorCount, dev) != hipSuccess) { grid = -1; return; }
        if (hipFuncSetAttribute((const void*)fwd, hipFuncAttributeMaxDynamicSharedMemorySize, LDS_BYTES) != hipSuccess) { fprintf(stderr, "kernel_launch: hipFuncSetAttribute failed\n"); grid = -1; return; }
        int per_cu = 0; (void)hipOccupancyMaxActiveBlocksPerMultiprocessor(&per_cu, (const void*)fwd, NWAVES * 64, LDS_BYTES); (void)hipGetLastError();
        if (per_cu < 1) fprintf(stderr, "kernel_launch: occupancy query reports %d blocks per CU\n", per_cu);
        grid = cus;
        if (grid != 256) { fprintf(stderr, "kernel_launch: this kernel needs a 256-CU device (got %d)\n", grid); grid = -1; return; }
    }
    if (grid < 0) return;
    (void)hipMemsetAsync((char*)d_ws + WS_CTL, 0, CTL_ZERO_BYTES, stream);
    Args a{};
    for (int i = 0; i < 18; ++i) a.in[i] = (const float*)d_in[i];
    a.out = (float*)d_out; a.ws = (unsigned char*)d_ws;
#if MK_ONE_LAUNCH
    a.ph_lo = 0; a.ph_hi = NPHASE;
    hipLaunchKernelGGL(fwd, dim3(grid), dim3(NWAVES * 64), LDS_BYTES, stream, a);
#else
    for (int p = 0; p < NPHASE; ++p) { a.ph_lo = p; a.ph_hi = p + 1;
        for (int rep = 0; rep < 1 + ((PROBE_DUP >> p) & 1) * PROBE_DUP_N; ++rep) hipLaunchKernelGGL(fwd, dim3(grid), dim3(NWAVES * 64), LDS_BYTES, stream, a); }
#endif
}
```

```cpp
#include <hip/hip_runtime.h>
#include <cstdio>
#include <cstdint>

#ifndef PROBE_DUP
#define PROBE_DUP 0
#define PROBE_DUP_N 1
#endif
#ifndef MK_ONE_LAUNCH
#define MK_ONE_LAUNCH 1
#endif

constexpr int BATCH = 4, SEQ = 4096, DM = 4096, T = BATCH * SEQ;
constexpr int NMEM = 256, TM = BATCH * NMEM;
constexpr int INW = 12304, IN_N = 12288, PROJ_LD = 6144;
constexpr int C_GQ = 0, C_GK = 1024, C_GV = 2048, C_GOUT = 4096;
constexpr size_t QKVH_T = (size_t)BATCH * 16 * SEQ * 128;
constexpr int DFF = 16384, U_LD = DFF + 64;
constexpr float EPS = 1e-6f;
constexpr int R8_LD = DFF + 128;
constexpr int RQ_LD = DFF + 128;
constexpr int IN_Q0 = 6144;

constexpr size_t MiB = 1u << 20;
constexpr size_t WS_CTL = 0, CTL_ZERO_BYTES = 32768;
constexpr size_t WS_RSTDX = 1 * MiB, WS_RSTD1 = WS_RSTDX + 65536, WS_RSTD2 = WS_RSTD1 + 65536;
constexpr size_t WS_ROPEC = 1 * MiB + 262144, WS_ROPES = WS_ROPEC + 262144, WS_KMEAN = WS_ROPES + 262144;
constexpr size_t WS_GLOW = 3 * MiB, WS_PART = 4 * MiB;
constexpr size_t WS_WIN = 8 * MiB, WS_WOUT = 104 * MiB, WS_WCKV = 136 * MiB, WS_WCQ = 200 * MiB, WS_WCO = 232 * MiB, WS_WUP = 264 * MiB, WS_WDN = 392 * MiB;
constexpr size_t WS_WQK = 520 * MiB, WS_WVO = 552 * MiB, WS_KCVC = 584 * MiB, WS_MEMN = 600 * MiB, WS_HB = 608 * MiB, WS_BIG = 736 * MiB, WS_DECAY = 1252 * MiB, WS_WGLOW = 1253 * MiB, WS_END = 1254 * MiB;
constexpr size_t WS_R8S = 336 * MiB;
constexpr size_t WS_UQ = 8 * MiB, WS_WDQ = 268 * MiB;
constexpr size_t WS_PROJ = WS_BIG, WS_QKVH = WS_BIG + 192 * MiB, WS_OMIX = WS_BIG + 384 * MiB, WS_P = WS_BIG, WS_U = WS_BIG;

#define GAS __attribute__((address_space(1)))
#define LAS __attribute__((address_space(3)))
typedef unsigned short bf16_t;
typedef short bf16x8 __attribute__((ext_vector_type(8)));
typedef short s16x4 __attribute__((ext_vector_type(4)));
typedef float f32x2 __attribute__((ext_vector_type(2)));
typedef float f32x4 __attribute__((ext_vector_type(4)));
typedef float f32x16 __attribute__((ext_vector_type(16)));
typedef unsigned u32x2 __attribute__((ext_vector_type(2)));
typedef unsigned u32x4 __attribute__((ext_vector_type(4)));
typedef int i32x4 __attribute__((ext_vector_type(4)));

__device__ __forceinline__ unsigned cvt_pk_bf16(float lo, float hi) { unsigned r; asm volatile("v_cvt_pk_bf16_f32 %0, %1, %2" : "=v"(r) : "v"(lo), "v"(hi)); return r; }
__device__ __forceinline__ float bf2f(unsigned short b) { return __uint_as_float(((unsigned)b) << 16); }
__device__ __forceinline__ float bflo(unsigned w) { return __uint_as_float(w << 16); }
__device__ __forceinline__ float bfhi(unsigned w) { return __uint_as_float(w & 0xffff0000u); }

namespace pg8 {
constexpr int BM = 256, BK = 64, HALF = 128, HTB = HALF * BK * 2, STAGE_BYTES = 8 * HTB, NXCD = 8, WGM = 8;
__host__ __device__ __forceinline__ int lds_byte(int r, int c) { const int st = (r >> 4) * 2 + (c >> 5), rr = r & 15, cc = c & 31, ob = rr * 64 + cc * 2; return st * 1024 + (ob ^ (((ob >> 9) & 1) << 5)); }
__host__ __device__ __forceinline__ void stage_rc(int b, int& R, int& C) { const int st = b / 1024, sb = b % 1024, swz = sb ^ (((sb >> 9) & 1) << 5); R = (st >> 1) * 16 + swz / 64; C = (st & 1) * 32 + (swz % 64) / 2; }
__host__ __device__ __forceinline__ int perm32(int rho) { const int n = rho >> 4, i = rho & 15; return 8 * (i >> 2) + 4 * n + (i & 3); }
struct Unit { int pm, pn; };

struct StaticOrder {
    int nM, nN, nwg, G, c;
    __device__ void init(int M, int N, int G_, int c_) { nM = M / BM; nN = N / BM; nwg = nM * nN; G = G_; c = c_; }
    __device__ __forceinline__ bool next(int i, Unit& u) const {
        const long L = (long)i * G + c; if (L >= nwg) return false;
        int wgid = (int)L; { const int q = nwg / NXCD, r = nwg % NXCD, xcd = wgid % NXCD, off = wgid / NXCD; wgid = (xcd < r ? xcd * (q + 1) : r * (q + 1) + (xcd - r) * q) + off; }
        const int nig = WGM * nN, gid = wgid / nig, fm = gid * WGM, gsz = (nM - fm) < WGM ? (nM - fm) : WGM;
        u.pm = fm + ((wgid % nig) % gsz); u.pn = (wgid % nig) / gsz; return true;
    }
};
struct LinearOrder {
    int n, G, c, base;
    __device__ __forceinline__ bool next(int i, Unit& u) const { const int L = i * G + c; if (L >= n) return false; u.pm = base + L; u.pn = 0; return true; }
};
struct StdPtrs {
    const char* A; const char* Bt; int K, lda, ldb, pmb; size_t bstride;
    __device__ __forceinline__ const char* a(const Unit& u) const { return A + (size_t)u.pm * BM * lda * 2; }
    __device__ __forceinline__ const char* b(const Unit& u) const { return Bt + (size_t)u.pn * BM * ldb * 2 + (pmb ? (size_t)(u.pm / pmb) * bstride : 0); }
};

template <bool I8> struct AccT { typedef f32x4 type; };
template <> struct AccT<true> { typedef i32x4 type; };
template <class Epi, class Sched, class Ptrs, bool ALIGN_EPI, bool I8 = false>
__device__ __forceinline__ void gemm_phase(LAS unsigned char* lds, const Ptrs& P, const Sched& S, const Epi& E) {
    const int tid = threadIdx.x, wid = __builtin_amdgcn_readfirstlane(tid >> 6), lane = tid & 63, wr = wid >> 2, wc = wid & 3, fr = lane & 15, fq = lane >> 4;
    const int K = P.K, nt = K / BK;
    unsigned voffA[2], voffB[2];
#pragma unroll
    for (int i = 0; i < 2; ++i) { int R, C; stage_rc(tid * 16 + i * 8192, R, C); const int Rb = Epi::PERM ? ((R & ~31) + perm32(R & 31)) : R;
        voffA[i] = (unsigned)(R * P.lda + C) * 2u; voffB[i] = (unsigned)(Rb * P.ldb + C) * 2u; }
    const size_t kstep = (size_t)(BK * 2);
    const size_t hstepA = (size_t)HALF * P.lda * 2, hstepB = (size_t)HALF * P.ldb * 2;
    const unsigned ldsw = (unsigned)wid * 1024u;
    const int aoff = lds_byte(wr * 64 + fr, fq * 8), boff = lds_byte(wc * 32 + fr, fq * 8);
#define PG8_SA(b, h) (((b) * 2 + (h)) * HTB)
#define PG8_SB(b, h) ((4 + (b) * 2 + (h)) * HTB)
#define PG8_STAGE(bufoff, gbase, voff) do { _Pragma("unroll") for (int _i = 0; _i < 2; ++_i) \
        __builtin_amdgcn_global_load_lds((const unsigned*)((const char*)(gbase) + (voff)[_i]), (LAS unsigned*)(lds + (bufoff) + ldsw + _i * 8192), 16, 0, 0); } while (0)
#define PG8_LDA(dst, b, h) do { _Pragma("unroll") for (int m = 0; m < 4; ++m) _Pragma("unroll") for (int k = 0; k < 2; ++k) dst[m][k] = *(const LAS bf16x8*)(lds + PG8_SA(b, h) + aoff + m * 2048 + k * 1024); } while (0)
#define PG8_LDB(dst, b, h) do { _Pragma("unroll") for (int n = 0; n < 2; ++n) _Pragma("unroll") for (int k = 0; k < 2; ++k) dst[n][k] = *(const LAS bf16x8*)(lds + PG8_SB(b, h) + boff + n * 2048 + k * 1024); } while (0)
#define PG8_MMA(ai, bj, At, Bt) do { __builtin_amdgcn_s_setprio(1); _Pragma("unroll") for (int m = 0; m < 4; ++m) _Pragma("unroll") for (int n = 0; n < 2; ++n) _Pragma("unroll") for (int k = 0; k < 2; ++k) { \
        if constexpr (I8) acc[ai][bj][m][n] = __builtin_amdgcn_mfma_i32_16x16x64_i8(__builtin_bit_cast(i32x4, Bt[n][k]), __builtin_bit_cast(i32x4, At[m][k]), acc[ai][bj][m][n], 0, 0, 0); \
        else acc[ai][bj][m][n] = __builtin_amdgcn_mfma_f32_16x16x32_bf16(Bt[n][k], At[m][k], acc[ai][bj][m][n], 0, 0, 0); } __builtin_amdgcn_s_setprio(0); } while (0)
#define PG8_WAIT_V(n) asm volatile("s_waitcnt vmcnt(" #n ")" ::: "memory")
#define PG8_WAIT_L(n) asm volatile("s_waitcnt lgkmcnt(" #n ")" ::: "memory")
#define PG8_BAR __builtin_amdgcn_s_barrier()
#define PG8_SCHED __builtin_amdgcn_sched_barrier(0)
    Unit cur, nxt; int ui = 0;
    if (!S.next(0, cur)) return;
    typedef typename AccT<I8>::type acc_t;
    acc_t acc[2][2][4][2];
#pragma unroll
    for (int a = 0; a < 2; ++a)
#pragma unroll
        for (int b = 0; b < 2; ++b)
#pragma unroll
            for (int m = 0; m < 4; ++m)
#pragma unroll
                for (int n = 0; n < 2; ++n) acc[a][b][m][n] = acc_t{};
    bf16x8 At[4][2], B0[2][2], B1[2][2];
    const char* cA = P.a(cur); const char* cB = P.b(cur);
    PG8_STAGE(PG8_SB(0, 0), cB, voffB); PG8_STAGE(PG8_SB(0, 1), cB + hstepB, voffB); PG8_STAGE(PG8_SA(0, 0), cA, voffA); PG8_STAGE(PG8_SA(0, 1), cA + hstepA, voffA);
    if (wr == 1) PG8_BAR;
    PG8_WAIT_V(2); PG8_BAR;
    PG8_STAGE(PG8_SB(1, 0), cB + kstep, voffB); PG8_STAGE(PG8_SA(1, 0), cA + kstep, voffA); PG8_STAGE(PG8_SB(1, 1), cB + hstepB + kstep, voffB);
    PG8_WAIT_V(6); PG8_BAR;
    for (;;) {
        const bool has_next = S.next(ui + 1, nxt);
        const char* nA = has_next ? P.a(nxt) : cA; const char* nB = has_next ? P.b(nxt) : cB;
        for (int t = 0; t < nt; t += 2) {
            const bool last = (t == nt - 2);
            const char* a1 = cA + (size_t)(t + 1) * kstep;
            const char* a2 = last ? nA : cA + (size_t)(t + 2) * kstep; const char* b2 = last ? nB : cB + (size_t)(t + 2) * kstep;
            const char* a3 = a2 + kstep; const char* b3 = b2 + kstep;
            PG8_LDB(B0, 0, 0); PG8_LDB(B1, 0, 1); PG8_SCHED; PG8_LDA(At, 0, 0); PG8_STAGE(PG8_SA(1, 1), a1 + hstepA, voffA);
            PG8_WAIT_V(8); PG8_WAIT_L(0); PG8_BAR; PG8_MMA(0, 0, At, B0); PG8_MMA(0, 1, At, B1); PG8_BAR; PG8_SCHED;
            PG8_LDA(At, 0, 1); PG8_STAGE(PG8_SB(0, 0), b2, voffB); PG8_STAGE(PG8_SB(0, 1), b2 + hstepB, voffB); PG8_STAGE(PG8_SA(0, 0), a2, voffA);
            PG8_WAIT_V(8); PG8_WAIT_L(0); PG8_BAR; PG8_MMA(1, 0, At, B0); PG8_MMA(1, 1, At, B1); PG8_BAR; PG8_SCHED;
            PG8_LDB(B0, 1, 0); PG8_LDB(B1, 1, 1); PG8_SCHED; PG8_LDA(At, 1, 0); PG8_STAGE(PG8_SA(0, 1), a2 + hstepA, voffA);
            PG8_WAIT_V(8); PG8_WAIT_L(0); PG8_BAR; PG8_MMA(0, 0, At, B0); PG8_MMA(0, 1, At, B1); PG8_BAR; PG8_SCHED;
            PG8_LDA(At, 1, 1); PG8_STAGE(PG8_SB(1, 0), b3, voffB); PG8_STAGE(PG8_SB(1, 1), b3 + hstepB, voffB); PG8_STAGE(PG8_SA(1, 0), a3, voffA);
            PG8_WAIT_V(8); PG8_WAIT_L(0); PG8_BAR; PG8_MMA(1, 0, At, B0); PG8_MMA(1, 1, At, B1); PG8_BAR; PG8_SCHED;
        }
        if constexpr (ALIGN_EPI) { if (wr == 0) PG8_BAR; }
        if constexpr (!Epi::AFTER_DRAIN) { E(acc, cur, wr, wc, fr, fq); }
        if (!has_next) break;
#pragma unroll
        for (int a = 0; a < 2; ++a)
#pragma unroll
            for (int b = 0; b < 2; ++b)
#pragma unroll
                for (int m = 0; m < 4; ++m)
#pragma unroll
                    for (int n = 0; n < 2; ++n) acc[a][b][m][n] = acc_t{};
        cur = nxt; cA = nA; cB = nB; ++ui;
        if constexpr (ALIGN_EPI) { if (wr == 1) PG8_BAR; }
    }
    PG8_WAIT_V(0);
    if constexpr (!ALIGN_EPI) { if (wr == 0) PG8_BAR; }
    PG8_BAR;
    if constexpr (Epi::AFTER_DRAIN) { E.fused(acc, cur, wr, wc, fr, fq, lds, wid, lane); }
#undef PG8_SA
#undef PG8_SB
#undef PG8_STAGE
#undef PG8_LDA
#undef PG8_LDB
#undef PG8_MMA
#undef PG8_WAIT_V
#undef PG8_WAIT_L
#undef PG8_BAR
#undef PG8_SCHED
}

template <int ACT, bool RS_LDS = false> struct EpiBf16 {
    static constexpr bool PERM = true, AFTER_DRAIN = false;
    bf16_t* O; int ldc; const float* rstd;
    __device__ __forceinline__ void operator()(const f32x4 (&acc)[2][2][4][2], const Unit& u, int wr, int wc, int fr, int fq) const {
        const int row0 = u.pm * BM + wr * 64 + fr, col0 = u.pn * BM + wc * 32 + 8 * fq;
        float rsv[2][4];
#pragma unroll
        for (int ai = 0; ai < 2; ++ai)
#pragma unroll
            for (int m = 0; m < 4; ++m) rsv[ai][m] = RS_LDS ? ((const LAS float*)131072)[wr * 64 + fr + ai * HALF + m * 16] : (rstd ? rstd[row0 + ai * HALF + m * 16] : 1.f);
#pragma unroll
        for (int ai = 0; ai < 2; ++ai)
#pragma unroll
            for (int m = 0; m < 4; ++m) { const int row = row0 + ai * HALF + m * 16; const float rs = rsv[ai][m]; bf16_t* rowp = O + (size_t)row * ldc + col0;
#pragma unroll
                for (int bj = 0; bj < 2; ++bj) { f32x4 v0 = acc[ai][bj][m][0] * rs, v1 = acc[ai][bj][m][1] * rs;
                    if (ACT == 1) {
#pragma unroll
                        for (int j = 0; j < 4; ++j) { const float a = fmaxf(v0[j], 0.f), b = fmaxf(v1[j], 0.f); v0[j] = a * a; v1[j] = b * b; } }
                    u32x4 w; w.x = cvt_pk_bf16(v0[0], v0[1]); w.y = cvt_pk_bf16(v0[2], v0[3]); w.z = cvt_pk_bf16(v1[0], v1[1]); w.w = cvt_pk_bf16(v1[2], v1[3]);
                    *(u32x4*)(rowp + bj * HALF) = w; } }
    }
};
struct EpiProjMoba {
    static constexpr bool PERM = true, AFTER_DRAIN = false;
    bf16_t* O; bf16_t* QH; const float* rowq; const float* cscale; const float* ropec; const float* ropes; int pn0;
    __device__ __forceinline__ void operator()(const i32x4 (&acc)[2][2][4][2], const Unit& u, int wr, int wc, int fr, int fq) const {
        const int row0 = u.pm * BM + wr * 64 + fr, col0 = u.pn * BM + wc * 32 + 8 * fq, pa = u.pn + pn0;
        f32x4 cs[2][2];
#pragma unroll
        for (int bj = 0; bj < 2; ++bj) { cs[bj][0] = *(const f32x4*)(cscale + col0 + bj * HALF); cs[bj][1] = *(const f32x4*)(cscale + col0 + bj * HALF + 4); }
        const bool hm = pa >= 24, rope = hm && (pa < 40) && (wc == 0);
        const int t3 = (pa - 24) >> 3, hp = (pa - 24) & 7;
        float rsv[2][4];
#pragma unroll
        for (int ai = 0; ai < 2; ++ai)
#pragma unroll
            for (int m = 0; m < 4; ++m) rsv[ai][m] = rowq[row0 + ai * HALF + m * 16];
        f32x4 nc0 = {1.f, 1.f, 1.f, 1.f}, nc1 = nc0, ns0 = {0.f, 0.f, 0.f, 0.f}, ns1 = ns0;
        if (rope) { const int pos = row0 & (SEQ - 1); const float* cp = ropec + pos * 16 + 8 * (fq & 1); const float* sp = ropes + pos * 16 + 8 * (fq & 1);
            nc0 = *(const f32x4*)cp; nc1 = *(const f32x4*)(cp + 4); ns0 = *(const f32x4*)sp; ns1 = *(const f32x4*)(sp + 4); }
#pragma unroll
        for (int ai = 0; ai < 2; ++ai)
#pragma unroll
            for (int m = 0; m < 4; ++m) { const int row = row0 + ai * HALF + m * 16; const float rs = rsv[ai][m];
                bf16_t* rowp = hm ? QH + (size_t)t3 * QKVH_T + ((size_t)((row >> 12) * 16 + 2 * hp) * SEQ + (row & (SEQ - 1))) * 128 + wc * 32 + 8 * fq : O + (size_t)row * PROJ_LD + pa * BM + wc * 32 + 8 * fq;
                const size_t bjstep = hm ? (size_t)SEQ * 128 : (size_t)HALF;
                f32x4 c0 = nc0, c1 = nc1, s0 = ns0, s1 = ns1;
                if (rope) {
                    if (ai * 4 + m < 7) { const int g1 = ai * 4 + m + 1, pos = (row0 + (g1 >> 2) * HALF + (g1 & 3) * 16) & (SEQ - 1); const float* cp = ropec + pos * 16 + 8 * (fq & 1); const float* sp = ropes + pos * 16 + 8 * (fq & 1);
                        nc0 = *(const f32x4*)cp; nc1 = *(const f32x4*)(cp + 4); ns0 = *(const f32x4*)sp; ns1 = *(const f32x4*)(sp + 4); }
                    if (fq < 2) { s0 = -s0; s1 = -s1; } }
#pragma unroll
                for (int bj = 0; bj < 2; ++bj) { const i32x4 a0 = acc[ai][bj][m][0], a1 = acc[ai][bj][m][1];
                    f32x4 v0 = (f32x4){(float)a0[0], (float)a0[1], (float)a0[2], (float)a0[3]} * cs[bj][0] * rs, v1 = (f32x4){(float)a1[0], (float)a1[1], (float)a1[2], (float)a1[3]} * cs[bj][1] * rs;
                    if (rope) { f32x4 p0, p1;
#pragma unroll
                        for (int j = 0; j < 4; ++j) { p0[j] = __shfl_xor(v0[j], 32); p1[j] = __shfl_xor(v1[j], 32); }
                        v0 = v0 * c0 + p0 * s0; v1 = v1 * c1 + p1 * s1; }
                    u32x4 w; w.x = cvt_pk_bf16(v0[0], v0[1]); w.y = cvt_pk_bf16(v0[2], v0[3]); w.z = cvt_pk_bf16(v1[0], v1[1]); w.w = cvt_pk_bf16(v1[2], v1[3]);
                    *(u32x4*)(rowp + bj * bjstep) = w; } }
    }
};
struct EpiUpI8 {
    static constexpr bool PERM = true, AFTER_DRAIN = false;
    unsigned char* O; float* S8; const float* rowq; const float* cscale;
    __device__ __forceinline__ void operator()(const i32x4 (&acc)[2][2][4][2], const Unit& u, int wr, int wc, int fr, int fq) const {
        const int row0 = u.pm * BM + wr * 64 + fr, col0 = u.pn * BM + wc * 32 + 8 * fq;
        f32x4 cs[2][2];
#pragma unroll
        for (int bj = 0; bj < 2; ++bj) { cs[bj][0] = *(const f32x4*)(cscale + col0 + bj * HALF); cs[bj][1] = *(const f32x4*)(cscale + col0 + bj * HALF + 4); }
        float rsv[2][4];
#pragma unroll
        for (int ai = 0; ai < 2; ++ai)
#pragma unroll
            for (int m = 0; m < 4; ++m) rsv[ai][m] = rowq[row0 + ai * HALF + m * 16];
#pragma unroll
        for (int ai = 0; ai < 2; ++ai)
#pragma unroll
            for (int m = 0; m < 4; ++m) { const int row = row0 + ai * HALF + m * 16; const float rs = rsv[ai][m]; unsigned char* rowp = O + (size_t)row * R8_LD + col0;
                f32x4 v[2][2]; float mx = 0.f;
#pragma unroll
                for (int bj = 0; bj < 2; ++bj) { const i32x4 a0 = acc[ai][bj][m][0], a1 = acc[ai][bj][m][1];
                    v[bj][0] = (f32x4){(float)a0[0], (float)a0[1], (float)a0[2], (float)a0[3]} * cs[bj][0] * rs; v[bj][1] = (f32x4){(float)a1[0], (float)a1[1], (float)a1[2], (float)a1[3]} * cs[bj][1] * rs;
#pragma unroll
                    for (int jj = 0; jj < 4; ++jj) { v[bj][0][jj] = fmaxf(v[bj][0][jj], 0.f); v[bj][1][jj] = fmaxf(v[bj][1][jj], 0.f); mx = fmaxf(mx, fmaxf(v[bj][0][jj], v[bj][1][jj])); } }
                mx = fmaxf(mx, __shfl_xor(mx, 16)); mx = fmaxf(mx, __shfl_xor(mx, 32));
                const float inv = mx > 0.f ? 255.0f / mx : 0.f;
                if (fq == 0) S8[(size_t)row * 256 + u.pn * 4 + wc] = mx * (1.0f / 255.0f);
#pragma unroll
                for (int bj = 0; bj < 2; ++bj) { u32x2 w; unsigned q = 0u;
#pragma unroll
                    for (int jj = 0; jj < 4; ++jj) q = __builtin_amdgcn_cvt_pk_u8_f32(rintf(v[bj][0][jj] * inv), jj, q);
                    w.x = q; q = 0u;
#pragma unroll
                    for (int jj = 0; jj < 4; ++jj) q = __builtin_amdgcn_cvt_pk_u8_f32(rintf(v[bj][1][jj] * inv), jj, q);
                    w.y = q; *(u32x2*)(rowp + bj * HALF) = w; } }
    }
};
template <bool BASE_F32> struct EpiResid {
    static constexpr bool PERM = true, AFTER_DRAIN = false;
    static_assert(!BASE_F32, "the residual base is bf16 in every phase of this kernel");
    const void* base; bf16_t* hout; float* part;
    __device__ __forceinline__ void operator()(const f32x4 (&acc)[2][2][4][2], const Unit& u, int wr, int wc, int fr, int fq) const {
        const int row0 = u.pm * BM + wr * 64 + fr, col0 = u.pn * BM + wc * 32 + 8 * fq;
#pragma unroll
        for (int ai = 0; ai < 2; ++ai) {
            u32x4 bw[4][2];
#pragma unroll
            for (int m = 0; m < 4; ++m)
#pragma unroll
                for (int bj = 0; bj < 2; ++bj) bw[m][bj] = *(const u32x4*)((const bf16_t*)base + (size_t)(row0 + ai * HALF + m * 16) * DM + col0 + bj * HALF);
#pragma unroll
            for (int m = 0; m < 4; ++m) { const int row = row0 + ai * HALF + m * 16; const size_t off = (size_t)row * DM + col0; float ss = 0.f;
#pragma unroll
                for (int bj = 0; bj < 2; ++bj) { const u32x4 w = bw[m][bj];
                    const f32x4 b0 = {bflo(w.x), bfhi(w.x), bflo(w.y), bfhi(w.y)}, b1 = {bflo(w.z), bfhi(w.z), bflo(w.w), bfhi(w.w)};
                    const f32x4 o0 = b0 + acc[ai][bj][m][0], o1 = b1 + acc[ai][bj][m][1];
                    ss += ((o0[0] * o0[0] + o0[1] * o0[1]) + (o0[2] * o0[2] + o0[3] * o0[3])) + ((o1[0] * o1[0] + o1[1] * o1[1]) + (o1[2] * o1[2] + o1[3] * o1[3]));
                    u32x4 w2; w2.x = cvt_pk_bf16(o0[0], o0[1]); w2.y = cvt_pk_bf16(o0[2], o0[3]); w2.z = cvt_pk_bf16(o1[0], o1[1]); w2.w = cvt_pk_bf16(o1[2], o1[3]);
                    *(u32x4*)(hout + off + bj * HALF) = w2; }
                ss += __shfl_xor(ss, 16); ss += __shfl_xor(ss, 32);
                if (fq == 0) part[(size_t)row * 64 + u.pn * 4 + wc] = ss; }
            asm volatile("" ::: "memory"); }
    }
};
struct EpiResidI8 {
    static constexpr bool PERM = true, AFTER_DRAIN = false;
    const bf16_t* base; bf16_t* hout; float* part; const float* sa; const float* mrow; const float* sw; const float* cw;
    __device__ __forceinline__ void operator()(const i32x4 (&acc)[2][2][4][2], const Unit& u, int wr, int wc, int fr, int fq) const {
        const int row0 = u.pm * BM + wr * 64 + fr, col0 = u.pn * BM + wc * 32 + 8 * fq;
        f32x4 cs[2][2], cc[2][2];
#pragma unroll
        for (int bj = 0; bj < 2; ++bj) { cs[bj][0] = *(const f32x4*)(sw + col0 + bj * HALF); cs[bj][1] = *(const f32x4*)(sw + col0 + bj * HALF + 4); cc[bj][0] = *(const f32x4*)(cw + col0 + bj * HALF); cc[bj][1] = *(const f32x4*)(cw + col0 + bj * HALF + 4); }
#pragma unroll
        for (int ai = 0; ai < 2; ++ai) {
            u32x4 bw[4][2]; float rs[4], rm[4];
#pragma unroll
            for (int m = 0; m < 4; ++m) { rs[m] = sa[row0 + ai * HALF + m * 16]; rm[m] = mrow[row0 + ai * HALF + m * 16];
#pragma unroll
                for (int bj = 0; bj < 2; ++bj) bw[m][bj] = *(const u32x4*)(base + (size_t)(row0 + ai * HALF + m * 16) * DM + col0 + bj * HALF); }
#pragma unroll
            for (int m = 0; m < 4; ++m) { const int row = row0 + ai * HALF + m * 16; const size_t off = (size_t)row * DM + col0; float ss = 0.f;
#pragma unroll
                for (int bj = 0; bj < 2; ++bj) { const u32x4 w = bw[m][bj]; const i32x4 a0 = acc[ai][bj][m][0], a1 = acc[ai][bj][m][1];
                    const f32x4 b0 = {bflo(w.x), bfhi(w.x), bflo(w.y), bfhi(w.y)}, b1 = {bflo(w.z), bfhi(w.z), bflo(w.w), bfhi(w.w)};
                    const f32x4 o0 = b0 + (f32x4){(float)a0[0], (float)a0[1], (float)a0[2], (float)a0[3]} * cs[bj][0] * rs[m] + cc[bj][0] * rm[m];
                    const f32x4 o1 = b1 + (f32x4){(float)a1[0], (float)a1[1], (float)a1[2], (float)a1[3]} * cs[bj][1] * rs[m] + cc[bj][1] * rm[m];
                    ss += ((o0[0] * o0[0] + o0[1] * o0[1]) + (o0[2] * o0[2] + o0[3] * o0[3])) + ((o1[0] * o1[0] + o1[1] * o1[1]) + (o1[2] * o1[2] + o1[3] * o1[3]));
                    u32x4 w2; w2.x = cvt_pk_bf16(o0[0], o0[1]); w2.y = cvt_pk_bf16(o0[2], o0[3]); w2.z = cvt_pk_bf16(o1[0], o1[1]); w2.w = cvt_pk_bf16(o1[2], o1[3]);
                    *(u32x4*)(hout + off + bj * HALF) = w2; }
                ss += __shfl_xor(ss, 16); ss += __shfl_xor(ss, 32);
                if (fq == 0) part[(size_t)row * 64 + u.pn * 4 + wc] = ss; }
            asm volatile("" ::: "memory"); }
    }
};
struct EpiSoftmax {
    static constexpr bool PERM = true, AFTER_DRAIN = true;
    bf16_t* Pm; const float* part;
    __device__ __forceinline__ void fused(f32x4 (&acc)[2][2][4][2], const Unit& u, int wr, int wc, int fr, int fq, LAS unsigned char* lds, int wid, int lane) const {
        LAS float* MX = (LAS float*)lds; LAS float* SM = (LAS float*)(lds + 4096); LAS float* RS = (LAS float*)(lds + 8192);
        const float C = 0.03125f * 1.4426950408889634f;
        { const int tid = wid * 64 + lane, rl = tid >> 1, hf = tid & 1; const f32x4* pp = (const f32x4*)(part + (size_t)(u.pm * BM + rl) * 64 + hf * 32); float s = 0.f;
#pragma unroll
          for (int j = 0; j < 8; ++j) { const f32x4 v = pp[j]; s += (v[0] + v[1]) + (v[2] + v[3]); }
          s += __shfl_xor(s, 1);
          if (hf == 0) RS[rl] = 1.0f / sqrtf(s * (1.0f / DM) + EPS); }
        asm volatile("s_waitcnt lgkmcnt(0)" ::: "memory"); __builtin_amdgcn_s_barrier(); asm volatile("" ::: "memory");
#pragma unroll
        for (int ai = 0; ai < 2; ++ai)
#pragma unroll
            for (int m = 0; m < 4; ++m) { const int r = ai * HALF + wr * 64 + m * 16 + fr; const float sc = RS[r] * C; float mx = -3.0e38f;
#pragma unroll
                for (int bj = 0; bj < 2; ++bj)
#pragma unroll
                    for (int n = 0; n < 2; ++n) { f32x4 v = acc[ai][bj][m][n] * sc; acc[ai][bj][m][n] = v; mx = fmaxf(fmaxf(mx, fmaxf(v[0], v[1])), fmaxf(v[2], v[3])); }
                mx = fmaxf(mx, __shfl_xor(mx, 16)); mx = fmaxf(mx, __shfl_xor(mx, 32));
                if (fq == 0) MX[r * 4 + wc] = mx; }
        asm volatile("s_waitcnt lgkmcnt(0)" ::: "memory"); __builtin_amdgcn_s_barrier(); asm volatile("" ::: "memory");
#pragma unroll
        for (int ai = 0; ai < 2; ++ai)
#pragma unroll
            for (int m = 0; m < 4; ++m) { const int r = ai * HALF + wr * 64 + m * 16 + fr; const f32x4 q = *(const LAS f32x4*)(MX + r * 4); const float M = fmaxf(fmaxf(q[0], q[1]), fmaxf(q[2], q[3])); float s = 0.f;
#pragma unroll
                for (int bj = 0; bj < 2; ++bj)
#pragma unroll
                    for (int n = 0; n < 2; ++n) { f32x4 v = acc[ai][bj][m][n];
#pragma unroll
                        for (int j = 0; j < 4; ++j) { v[j] = __builtin_amdgcn_exp2f(v[j] - M); s += v[j]; }
                        acc[ai][bj][m][n] = v; }
                s += __shfl_xor(s, 16); s += __shfl_xor(s, 32);
                if (fq == 0) SM[r * 4 + wc] = s; }
        asm volatile("s_waitcnt lgkmcnt(0)" ::: "memory"); __builtin_amdgcn_s_barrier(); asm volatile("" ::: "memory");
        const int col0 = u.pn * BM + wc * 32 + 8 * fq;
#pragma unroll
        for (int ai = 0; ai < 2; ++ai)
#pragma unroll
            for (int m = 0; m < 4; ++m) { const int r = ai * HALF + wr * 64 + m * 16 + fr; const f32x4 q = *(const LAS f32x4*)(SM + r * 4); const float inv = 1.0f / ((q[0] + q[1]) + (q[2] + q[3]));
                bf16_t* rowp = Pm + (size_t)(u.pm * BM + r) * 1024 + col0;
#pragma unroll
                for (int bj = 0; bj < 2; ++bj) { const f32x4 v0 = acc[ai][bj][m][0] * inv, v1 = acc[ai][bj][m][1] * inv;
                    u32x4 w; w.x = cvt_pk_bf16(v0[0], v0[1]); w.y = cvt_pk_bf16(v0[2], v0[3]); w.z = cvt_pk_bf16(v1[0], v1[1]); w.w = cvt_pk_bf16(v1[2], v1[3]);
                    *(u32x4*)(rowp + bj * HALF) = w; } }
    }
};
struct QkVoPtrs {
    const char* kcvc; const char* wcq; const char* wcoT; int K, lda, ldb;
    __device__ __forceinline__ const char* a(const Unit& u) const { const int L = u.pm; if (L < 256) { const int bh = L >> 4, b = bh >> 2, h = bh & 3; return kcvc + ((size_t)(b * 256) * 8192 + h * 1024) * 2; }
        const int L2 = L - 256, bh = L2 >> 4, h = bh & 3, nt = L2 & 15; return wcoT + ((size_t)(nt * 256) * 4096 + h * 1024) * 2; }
    __device__ __forceinline__ const char* b(const Unit& u) const { const int L = u.pm; if (L < 256) { const int bh = L >> 4, h = bh & 3, kt = L & 15; return wcq + ((size_t)(kt * 256) * 4096 + h * 1024) * 2; }
        const int L2 = L - 256, bh = L2 >> 4, b = bh >> 2, h = bh & 3; return kcvc + ((size_t)(b * 256) * 8192 + 4096 + h * 1024) * 2; }
};
struct EpiQkVo {
    static constexpr bool PERM = true, AFTER_DRAIN = false;
    bf16_t* WqkT; bf16_t* WvoT;
    __device__ __forceinline__ void operator()(const f32x4 (&acc)[2][2][4][2], const Unit& u, int wr, int wc, int fr, int fq) const {
        const int L = u.pm; bf16_t* base; int ldc;
        if (L < 256) { const int bh = L >> 4, b = bh >> 2, h = bh & 3, kt = L & 15; base = WqkT + ((size_t)(b * 1024 + h * 256)) * 4096 + kt * 256; ldc = 4096; }
        else { const int L2 = L - 256, bh = L2 >> 4, b = bh >> 2, h = bh & 3, nt = L2 & 15; base = WvoT + ((size_t)b * 4096 + nt * 256) * 1024 + h * 256; ldc = 1024; }
        const int row0 = wr * 64 + fr, col0 = wc * 32 + 8 * fq;
#pragma unroll
        for (int ai = 0; ai < 2; ++ai)
#pragma unroll
            for (int m = 0; m < 4; ++m) { bf16_t* rowp = base + (size_t)(row0 + ai * HALF + m * 16) * ldc + col0;
#pragma unroll
                for (int bj = 0; bj < 2; ++bj) { const f32x4 v0 = acc[ai][bj][m][0], v1 = acc[ai][bj][m][1];
                    u32x4 w; w.x = cvt_pk_bf16(v0[0], v0[1]); w.y = cvt_pk_bf16(v0[2], v0[3]); w.z = cvt_pk_bf16(v1[0], v1[1]); w.w = cvt_pk_bf16(v1[2], v1[3]);
                    *(u32x4*)(rowp + bj * HALF) = w; } }
    }
};
}

namespace mb {
constexpr int D = 128, NW = 8, QBLK = 32, KVBLK = 64, QB = NW * QBLK;
constexpr int SHM_V = KVBLK * D * 2, SHM_K = KVBLK * D * 2;
constexpr int KM_OFF = 2 * SHM_V + 2 * SHM_K + NW * 64 * 4;
constexpr int ATT_LDS = KM_OFF + 8192;
constexpr int OSTG_OFF = 77824;
constexpr int LDQ = 128, LDO = DM;
constexpr float SCALE = 0.08838834764831845f;
constexpr float THR = 8.f;
#define KSWZ(row, colB) ((row) * 256 + ((colB) ^ (((row) & 7) << 4)))
#define SBAR() __builtin_amdgcn_sched_barrier(0)
__device__ __forceinline__ int v_st(int k, int c) { const int kk = (k & ~0xC) | ((k & 4) << 1) | ((k & 8) >> 1); return ((kk >> 3) * 4 + (c >> 5)) * 512 + ((kk & 7) * 32 + (c & 31)) * 2; }
__device__ __forceinline__ int v_rd_base(int lane) { return ((lane & 3) << 3) | (((lane >> 2) & 3) << 6) | (((lane >> 4) & 1) << 5) | (((lane >> 5) & 1) << 8); }
constexpr int v_rd_off(int d0, int ks, int half) { return d0 * 512 + ks * 4096 + half * 2048; }
__device__ __forceinline__ int crow(int r, int hi) { return (r & 3) + 8 * (r >> 2) + 4 * hi; }
__device__ __forceinline__ bf16x8 load8(const bf16_t* p) { return *reinterpret_cast<const bf16x8*>(p); }
__device__ __forceinline__ void mask_causal(f32x16& p0, f32x16& p1, int dq) {
    const float NEG = -__builtin_inff();
#pragma unroll
    for (int r = 0; r < 16; ++r) {
        const int c = (r & 3) + 8 * (r >> 2);
        if (dq - c < 0) p0[r] = NEG;
        if (dq - c - 32 < 0) p1[r] = NEG;
    }
}
__device__ __forceinline__ void partialSM(f32x16& p0, f32x16& p1, float& m_reg, float& mn, float& alpha, bool allow) {
    float pmax = p0[0];
#pragma unroll
    for (int r = 1; r < 16; ++r) pmax = fmaxf(pmax, p0[r]);
#pragma unroll
    for (int r = 0; r < 16; ++r) pmax = fmaxf(pmax, p1[r]);
    { auto rr = __builtin_amdgcn_permlane32_swap(__float_as_uint(pmax), __float_as_uint(pmax), false, false);
      pmax = fmaxf(__uint_as_float(rr[0]), __uint_as_float(rr[1])); }
    pmax = allow ? pmax : -__builtin_inff();
    constexpr float C2 = 1.4426950408889634f * SCALE;
    if (__builtin_expect(__all((pmax - m_reg) * SCALE <= THR), 1)) { mn = m_reg; alpha = 1.f; }
    else { mn = fmaxf(m_reg, pmax); alpha = __builtin_amdgcn_exp2f((m_reg - mn) * C2); m_reg = mn; }
    const float mnL = allow ? -mn * C2 : -__builtin_inff();
#pragma unroll
    for (int r = 0; r < 16; ++r) p0[r] = fmaf(p0[r], C2, mnL);
#pragma unroll
    for (int r = 0; r < 16; ++r) p1[r] = fmaf(p1[r], C2, mnL);
#pragma unroll
    for (int r = 0; r < 16; ++r) p0[r] = __builtin_amdgcn_exp2f(p0[r]);
}
__device__ __forceinline__ void finishSM(f32x16& p0, f32x16& p1, float alpha, float& l_reg, bf16x8& pa0, bf16x8& pa1, bf16x8& pa2, bf16x8& pa3) {
#pragma unroll
    for (int r = 0; r < 16; ++r) p1[r] = __builtin_amdgcn_exp2f(p1[r]);
    float ps = 0;
#pragma unroll
    for (int r = 0; r < 16; ++r) ps += p0[r];
#pragma unroll
    for (int r = 0; r < 16; ++r) ps += p1[r];
    { auto rr = __builtin_amdgcn_permlane32_swap(__float_as_uint(ps), __float_as_uint(ps), false, false);
      ps = __uint_as_float(rr[0]) + __uint_as_float(rr[1]); }
    l_reg = l_reg * alpha + ps;
#define PK4(P, B_, OUT) do { unsigned a0 = cvt_pk_bf16(P[B_+0], P[B_+1]), a1 = cvt_pk_bf16(P[B_+2], P[B_+3]);                          \
        unsigned b0 = cvt_pk_bf16(P[B_+4], P[B_+5]), b1 = cvt_pk_bf16(P[B_+6], P[B_+7]);                                             \
        auto r0 = __builtin_amdgcn_permlane32_swap(a0, b0, false, false); auto r1 = __builtin_amdgcn_permlane32_swap(a1, b1, false, false); \
        u32x4 w = {r0[0], r1[0], r0[1], r1[1]}; OUT = *reinterpret_cast<bf16x8*>(&w); } while (0)
    PK4(p0, 0, pa0); PK4(p0, 8, pa1); PK4(p1, 0, pa2); PK4(p1, 8, pa3);
#undef PK4
}
template <int KB>
__device__ __forceinline__ void qkt(f32x16& p0, f32x16& p1, const char* K_lds, int r32, int hi, const bf16x8* qr) {
    p0 = f32x16{}; p1 = f32x16{};
    const char* kb[4];
#pragma unroll
    for (int dd = 0; dd < 4; ++dd) kb[dd] = K_lds + KB * SHM_K + KSWZ(r32, (dd * 16 + hi * 8) * 2);
#pragma unroll
    for (int d0 = 0; d0 < 8; ++d0) { const char* a = kb[d0 & 3] + (d0 >> 2) * 128;
        bf16x8 b0 = *reinterpret_cast<const bf16x8*>(a);
        bf16x8 b1 = *reinterpret_cast<const bf16x8*>(a + 32 * 256);
        p0 = __builtin_amdgcn_mfma_f32_32x32x16_bf16(b0, qr[d0], p0, 0, 0, 0);
        p1 = __builtin_amdgcn_mfma_f32_32x32x16_bf16(b1, qr[d0], p1, 0, 0, 0); }
}
template <int VB>
__device__ __forceinline__ void pv_tile(f32x16* o, int vb0, bf16x8 pa0, bf16x8 pa1, bf16x8 pa2, bf16x8 pa3) {
#define TRRD(dst, off) asm volatile("ds_read_b64_tr_b16 %0, %1 offset:%2" : "=&v"(dst) : "v"(vb0), "i"(off) : "memory")
#define PV_D0(d0) do { s16x4 l0, l1, l2, l3, h0, h1, h2, h3; constexpr int b_ = VB * SHM_V + v_rd_off(d0, 0, 0); \
        TRRD(l0, b_); TRRD(h0, b_ + 2048); TRRD(l1, b_ + 4096); TRRD(h1, b_ + 6144); TRRD(l2, b_ + 8192); TRRD(h2, b_ + 10240); TRRD(l3, b_ + 12288); TRRD(h3, b_ + 14336); \
        asm volatile("s_waitcnt lgkmcnt(0)" ::: "memory"); SBAR();   \
        o[d0] = __builtin_amdgcn_mfma_f32_32x32x16_bf16(pa0, (bf16x8){l0[0], l0[1], l0[2], l0[3], h0[0], h0[1], h0[2], h0[3]}, o[d0], 0, 0, 0);   \
        o[d0] = __builtin_amdgcn_mfma_f32_32x32x16_bf16(pa1, (bf16x8){l1[0], l1[1], l1[2], l1[3], h1[0], h1[1], h1[2], h1[3]}, o[d0], 0, 0, 0);   \
        o[d0] = __builtin_amdgcn_mfma_f32_32x32x16_bf16(pa2, (bf16x8){l2[0], l2[1], l2[2], l2[3], h2[0], h2[1], h2[2], h2[3]}, o[d0], 0, 0, 0);   \
        o[d0] = __builtin_amdgcn_mfma_f32_32x32x16_bf16(pa3, (bf16x8){l3[0], l3[1], l3[2], l3[3], h3[0], h3[1], h3[2], h3[3]}, o[d0], 0, 0, 0); } while (0)
    PV_D0(0); PV_D0(1); PV_D0(2); PV_D0(3);
#undef PV_D0
#undef TRRD
}
struct BlockRef { const bf16_t* Q; const bf16_t* K; const bf16_t* V; bf16_t* O; const float* km; int qb; };
struct Seam { bf16x8 qr[8]; bf16x8 st_v0, st_v1, st_k0, st_k1; };
#define ROWU(p, k0, half) ((const bf16_t*)((const char*)(p) + (size_t)((k0) + (half) * 32) * (LDQ * 2) + lane_ld))
#define VMW() asm volatile("s_waitcnt vmcnt(0)" ::: "memory")
#define VMWN(n) asm volatile("s_waitcnt vmcnt(%0)" :: "i"(n) : "memory")
#define SLOAD_H(Kp, Vp, k0) do { S.st_v0 = load8(ROWU(Vp, k0, 0)); S.st_v1 = load8(ROWU(Vp, k0, 1));              \
                         S.st_k0 = load8(ROWU(Kp, k0, 0)); S.st_k1 = load8(ROWU(Kp, k0, 1)); } while (0)
#define SWRITE_HK(bf) do { *(bf16x8*)(K_lds + (bf) * SHM_K + kws) = S.st_k0; *(bf16x8*)(K_lds + (bf) * SHM_K + kws + 32 * 256) = S.st_k1; } while (0)
#define SWRITE_HV(bf) do { *(bf16x8*)(V_lds + (bf) * SHM_V + vst0) = S.st_v0; *(bf16x8*)(V_lds + (bf) * SHM_V + vst1) = S.st_v1; } while (0)
#define SWRITE_H(bf) do { SWRITE_HV(bf); SWRITE_HK(bf); } while (0)
__device__ __forceinline__ void moba_prime(const BlockRef& cur, char* lds, Seam& S) {
    int tid_ = threadIdx.x; asm volatile("" : "+v"(tid_));
    const int tid = tid_, wid = __builtin_amdgcn_readfirstlane(tid >> 6), lane = tid & 63, r32 = lane & 31, hi = lane >> 5;
    const int sr = tid >> 4, sc = (tid & 15) * 8, kws = KSWZ(sr, sc * 2); char* K_lds = lds + 2 * SHM_V;
    const unsigned lane_ld = (unsigned)((sr * LDQ + sc) * 2);
#pragma unroll
    for (int d0 = 0; d0 < 8; ++d0) S.qr[d0] = load8(cur.Q + (size_t)(wid * QBLK + r32) * LDQ + d0 * 16 + hi * 8);
    SLOAD_H(cur.K, cur.V, 0); VMW(); SWRITE_HK(0);
    __syncthreads();
}
__device__ __forceinline__ void moba_block(const BlockRef& cur, const BlockRef& nxt, char* lds, Seam& S) {
    int tid_ = threadIdx.x; asm volatile("" : "+v"(tid_));
    const int tid = tid_, wid = __builtin_amdgcn_readfirstlane(tid >> 6), lane = tid & 63, r32 = lane & 31, hi = lane >> 5;
    const int qb = cur.qb, P0 = qb * QB;
    const int NT = (P0 + QB) / KVBLK;
    const int qlo = P0 + wid * QBLK, qm = qlo + r32 - 4 * hi;
    char* V_lds = lds; char* K_lds = lds + 2 * SHM_V;
    float* ws = (float*)(lds + 2 * SHM_V + 2 * SHM_K) + wid * 64; float* li_l = ws, * al_l = ws + 32;
    float* KM = (float*)(lds + KM_OFF);
    *(f32x4*)(KM + tid * 4) = *(const f32x4*)(cur.km + tid * 4);
    __syncthreads();
    unsigned mrow;
    if (qb <= 3) mrow = (2u << qb) - 1u;
    else {
        float g[15];
#pragma unroll
        for (int n = 0; n < 15; ++n) { g[n] = -__builtin_inff();
            if (n < qb) { float a = 0.f; const float* km = KM + n * 128 + hi * 8;
#pragma unroll
                for (int d0 = 0; d0 < 8; ++d0) { const bf16x8 q = S.qr[d0]; const f32x4 k0 = *(const f32x4*)(km + d0 * 16), k1 = *(const f32x4*)(km + d0 * 16 + 4);
                    a += bf2f((unsigned short)q[0]) * k0[0]; a += bf2f((unsigned short)q[1]) * k0[1]; a += bf2f((unsigned short)q[2]) * k0[2]; a += bf2f((unsigned short)q[3]) * k0[3];
                    a += bf2f((unsigned short)q[4]) * k1[0]; a += bf2f((unsigned short)q[5]) * k1[1]; a += bf2f((unsigned short)q[6]) * k1[2]; a += bf2f((unsigned short)q[7]) * k1[3]; }
                a += __shfl_xor(a, 32); g[n] = a; } }
        unsigned taken = 0u;
#pragma unroll
        for (int rep = 0; rep < 3; ++rep) { float best = -__builtin_inff(); int bi = 0;
#pragma unroll
            for (int n = 0; n < 15; ++n) { const bool c = (g[n] > best); best = c ? g[n] : best; bi = c ? n : bi; }
            taken |= 1u << bi;
#pragma unroll
            for (int n = 0; n < 15; ++n) g[n] = (n == bi) ? -__builtin_inff() : g[n]; }
        mrow = taken | (1u << qb);
    }
    float m_reg = -1e30f, l_reg = 0; f32x16 o[4] = {};
    const int sr = tid >> 4, sc = (tid & 15) * 8, vst0 = v_st(sr, sc), vst1 = v_st(32 + sr, sc), kws = KSWZ(sr, sc * 2);
    const unsigned lane_ld = (unsigned)((sr * LDQ + sc) * 2);
    const int vb0 = (int)(uintptr_t)V_lds + v_rd_base(lane);
    const bf16_t* Kh = cur.K; const bf16_t* Vh = cur.V;
#define RESC(a) do { if (__any((a) < 1.f)) { if (hi == 0) al_l[r32] = (a); asm volatile("s_waitcnt lgkmcnt(0)" ::: "memory");              \
                     for (int d_ = 0; d_ < 4; ++d_) for (int r = 0; r < 16; ++r) o[d_][r] *= al_l[crow(r, hi)]; } } while (0)
#define KBASE(t) ((t) * KVBLK)
#define MASKT(P0_, P1_, t) do { if (((t) >> 2) == qb) { if (KBASE(t) + KVBLK - 1 > qlo) mask_causal(P0_, P1_, qm - KBASE(t)); } } while (0)
#define ALLOWT(t) (((mrow >> ((t) >> 2)) & 1u) != 0u)
    constexpr int NQL = 8;
#define SEAM_K0() do { VMWN(NQL); SWRITE_HK(0); SBAR(); } while (0)
    f32x16 pA0, pA1, pB0, pB1; float mnA, mnB, alA, alB; bf16x8 pa0, pa1, pa2, pa3;
    SWRITE_HV(0); SBAR();
    if (NT > 1) SLOAD_H(Kh, Vh, KBASE(1));
    SBAR(); qkt<0>(pA0, pA1, K_lds, r32, hi, S.qr);
    MASKT(pA0, pA1, 0); partialSM(pA0, pA1, m_reg, mnA, alA, ALLOWT(0));
    if (NT > 1) { VMW(); SWRITE_H(1); }
    __syncthreads();
#define HALF_STEP(PX0, PX1, mnX, alX, PY0, PY1, alY, t, KB, VB, SB) do {                                                      \
        SBAR(); qkt<KB>(PX0, PX1, K_lds, r32, hi, S.qr);                                             \
        finishSM(PY0, PY1, alY, l_reg, pa0, pa1, pa2, pa3); SBAR();                                                           \
        if ((t) + 1 < NT) { SLOAD_H(Kh, Vh, KBASE((t) + 1)); SBAR(); }                                               \
        pv_tile<VB>(o, vb0, pa0, pa1, pa2, pa3); MASKT(PX0, PX1, (t)); partialSM(PX0, PX1, m_reg, mnX, alX, ALLOWT(t));                                        \
        __syncthreads();                                                                                                      \
        if ((t) + 1 < NT) { VMW(); SWRITE_H(SB); }                                                                          \
        RESC(alX); __syncthreads(); } while (0)
    if (wid >= 4) __builtin_amdgcn_s_setprio(1);
    for (int t = 1; t + 1 < NT; t += 2) {
        HALF_STEP(pB0, pB1, mnB, alB, pA0, pA1, alA, t, 1, 0, 0);
        HALF_STEP(pA0, pA1, mnA, alA, pB0, pB1, alB, t + 1, 0, 1, 1);
    }
    __builtin_amdgcn_s_setprio(0);
    SBAR(); qkt<1>(pB0, pB1, K_lds, r32, hi, S.qr); SBAR();
    SLOAD_H(nxt.K, nxt.V, 0); SBAR();
#pragma unroll
    for (int d0 = 0; d0 < 8; ++d0) S.qr[d0] = load8(nxt.Q + (size_t)(wid * QBLK + r32) * LDQ + d0 * 16 + hi * 8);
    SBAR();
    finishSM(pA0, pA1, alA, l_reg, pa0, pa1, pa2, pa3); SBAR();
    pv_tile<0>(o, vb0, pa0, pa1, pa2, pa3);
    MASKT(pB0, pB1, NT - 1); partialSM(pB0, pB1, m_reg, mnB, alB, true); __syncthreads(); RESC(alB);
    finishSM(pB0, pB1, alB, l_reg, pa0, pa1, pa2, pa3); SBAR(); pv_tile<1>(o, vb0, pa0, pa1, pa2, pa3);
    SBAR(); SEAM_K0();
    if (hi == 0) li_l[r32] = l_reg; asm volatile("s_waitcnt lgkmcnt(0)" ::: "memory");
    float rli[16];
#pragma unroll
    for (int r = 0; r < 16; ++r) rli[r] = __builtin_amdgcn_rcpf(li_l[crow(r, hi)]);
    char* Ow = (char*)(cur.O + (size_t)(wid * QBLK) * LDO);
    char* stg = lds + OSTG_OFF + wid * 4608;
    unsigned st_w = (unsigned)(4 * hi * 144 + r32 * 2), st_r = (unsigned)((lane >> 3) * 144 + (lane & 7) * 16), g_off = (unsigned)((lane >> 3) * (LDO * 2) + (lane & 7) * 16);
    asm volatile("" : "+v"(st_w), "+v"(st_r), "+v"(g_off));
#pragma unroll
    for (int h2 = 0; h2 < 2; ++h2) {
#pragma unroll
        for (int r = 0; r < 16; ++r)
#pragma unroll
            for (int dd = 0; dd < 2; ++dd) { const float v = o[2 * h2 + dd][r] * rli[r]; const float vn = __shfl_xor(v, 1);
                if ((r32 & 1) == 0) *(unsigned*)(stg + ((r & 3) + 8 * (r >> 2)) * 144 + dd * 64 + st_w) = cvt_pk_bf16(v, vn); }
        asm volatile("s_waitcnt lgkmcnt(0)" ::: "memory");
#pragma unroll
        for (int j = 0; j < 4; ++j) { const u32x4 w = *(const u32x4*)(stg + j * 8 * 144 + st_r); *(u32x4*)(Ow + (size_t)j * 8 * (LDO * 2) + h2 * 128 + g_off) = w; }
        asm volatile("s_waitcnt lgkmcnt(0)" ::: "memory");
    }
    __syncthreads();
#undef RESC
#undef KBASE
#undef MASKT
#undef ALLOWT
#undef SEAM_K0
#undef HALF_STEP
}
#undef ROWU
#undef VMW
#undef VMWN
#undef SLOAD_H
#undef SWRITE_HK
#undef SWRITE_HV
#undef SWRITE_H
}


namespace gla {
constexpr int L_SEG = 0, L_BT = 2048;
constexpr int GA_E = 4096, GA_KI = 38912, GA_VT = 55296;
constexpr int L_QD = 4096, L_KI = L_QD + 17408, L_VT = 38912, L_AT = 71680, L_OT = 4096;
__device__ __forceinline__ int crow(int r, int hi) { return (r & 3) + 8 * (r >> 2) + 4 * hi; }
__device__ __forceinline__ unsigned short f2bf1(float x) { return (unsigned short)(cvt_pk_bf16(x, 0.f) & 0xffffu); }
#define GLA_TRRD(dst, base, off) asm volatile("ds_read_b64_tr_b16 %0, %1 offset:%2" : "=&v"(dst) : "v"(base), "i"(off) : "memory")
#define GLA_FRAG(dst, base, d0, ks) do { s16x4 l_, h_; GLA_TRRD(l_, base, (d0) * 512 + (ks) * 4096); GLA_TRRD(h_, base, (d0) * 512 + (ks) * 4096 + 2048); \
        asm volatile("s_waitcnt lgkmcnt(0)" ::: "memory"); __builtin_amdgcn_sched_barrier(0); dst = (bf16x8){l_[0], l_[1], l_[2], l_[3], h_[0], h_[1], h_[2], h_[3]}; } while (0)
__device__ __forceinline__ float prep_b(LAS unsigned char* lds, const float* glow_rows, const float (&wg)[16], float bg, int k, int seg, float (&bv)[16]) {
    float cum = 0.f;
#pragma unroll
    for (int j = 0; j < 16; ++j) { const float* gl = glow_rows + (16 * seg + j) * 16; float z = bg;
#pragma unroll
        for (int r = 0; r < 16; ++r) z += gl[r] * wg[r];
        const float ls = fminf(z, 0.f) - __logf(1.0f + __expf(-fabsf(z)));
        cum += ls * (1.0f / 16.0f); bv[j] = cum; }
    LAS float* SEG = (LAS float*)(lds + L_SEG);
    SEG[seg * 128 + k] = cum;
    __syncthreads();
    float pre = 0.f, tot = 0.f;
#pragma unroll
    for (int s2 = 0; s2 < 4; ++s2) { const float v = SEG[s2 * 128 + k]; tot += v; pre += (s2 < seg) ? v : 0.f; }
#pragma unroll
    for (int j = 0; j < 16; ++j) bv[j] += pre;
    if (seg == 0) ((LAS float*)(lds + L_BT))[k] = __expf(tot);
    return tot;
}
__device__ __forceinline__ void load_v(u32x4 (&vr)[4], const bf16_t* vsrc, int tid) {
    const int t = tid >> 3, v0 = (tid & 7) * 32;
#pragma unroll
    for (int j = 0; j < 4; ++j) vr[j] = *(const u32x4*)(vsrc + (size_t)t * PROJ_LD + v0 + 8 * j);
}
__device__ __forceinline__ void store_v(LAS unsigned char* lds, int off, const u32x4 (&vr)[4], int tid) {
    const int t = tid >> 3, v0 = (tid & 7) * 32;
#pragma unroll
    for (int j = 0; j < 4; ++j) { const int c = v0 + 8 * j; *(LAS u32x4*)(lds + off + (c >> 7) * 16384 + mb::v_st(t, c & 127)) = vr[j]; }
}
__device__ __forceinline__ void ga_unit(LAS unsigned char* lds, int unit, bf16_t* proj, const float* glow, const float* w_gate_up, const float* b_gate, bf16_t* dSt, float* decay, int tid, int wave, int lane) {
    const int n = unit & 63, bh = unit >> 6, b = bh >> 3, h = bh & 7;
    const size_t row0 = (size_t)b * SEQ + n * 64;
    const int k = tid & 127, seg = __builtin_amdgcn_readfirstlane(tid >> 7);
    const int t = tid >> 3, c0 = (tid & 7) * 16;
    bf16_t* qp = proj + (row0 + t) * PROJ_LD + C_GQ + h * 128 + c0; bf16_t* kp = qp + (C_GK - C_GQ);
    const u32x4 q0 = *(const u32x4*)qp, q1 = *(const u32x4*)(qp + 8), k0 = *(const u32x4*)kp, k1 = *(const u32x4*)(kp + 8);
    u32x4 vr[4]; load_v(vr, proj + row0 * PROJ_LD + C_GV + h * 256, tid);
    float wg[16];
#pragma unroll
    for (int r = 0; r < 16; ++r) wg[r] = w_gate_up[r * 1024 + h * 128 + k];
    float bv[16];
    const float tot = prep_b(lds, glow + row0 * 16, wg, b_gate[h * 128 + k], k, seg, bv);
#pragma unroll
    for (int j = 0; j < 16; ++j) *(LAS float*)(lds + GA_E + ((16 * seg + j) * 132 + k) * 4) = __expf(bv[j]);
    if (seg == 0) decay[(size_t)unit * 128 + k] = __expf(tot);
    store_v(lds, GA_VT, vr, tid);
    __syncthreads();
    {
        const LAS f32x4* ep = (const LAS f32x4*)(lds + GA_E + (t * 132 + c0) * 4); f32x4 e[4];
#pragma unroll
        for (int i = 0; i < 4; ++i) e[i] = ep[i];
        const unsigned qw[8] = {q0.x, q0.y, q0.z, q0.w, q1.x, q1.y, q1.z, q1.w}, kw[8] = {k0.x, k0.y, k0.z, k0.w, k1.x, k1.y, k1.z, k1.w}; unsigned qo[8], ko[8];
#pragma unroll
        for (int i = 0; i < 8; ++i) { const float e0 = e[i >> 1][(i & 1) * 2], e1 = e[i >> 1][(i & 1) * 2 + 1];
            qo[i] = cvt_pk_bf16(bflo(qw[i]) * 0.08838834764831845f * e0, bfhi(qw[i]) * 0.08838834764831845f * e1);
            ko[i] = cvt_pk_bf16(bflo(kw[i]) * __builtin_amdgcn_rcpf(e0), bfhi(kw[i]) * __builtin_amdgcn_rcpf(e1)); }
        const u32x4 qa = {qo[0], qo[1], qo[2], qo[3]}, qb = {qo[4], qo[5], qo[6], qo[7]}, ka = {ko[0], ko[1], ko[2], ko[3]}, kb = {ko[4], ko[5], ko[6], ko[7]};
        *(u32x4*)qp = qa; *(u32x4*)(qp + 8) = qb; *(u32x4*)kp = ka; *(u32x4*)(kp + 8) = kb;
        *(LAS u32x4*)(lds + GA_KI + mb::v_st(t, c0)) = ka; *(LAS u32x4*)(lds + GA_KI + mb::v_st(t, c0 + 8)) = kb;
    }
    __syncthreads();
    const int r = lane & 31, hh = lane >> 5;
    const int kbase = (int)(uintptr_t)(lds + GA_KI) + mb::v_rd_base(lane), vbase = (int)(uintptr_t)(lds + GA_VT + (wave >> 2) * 16384) + mb::v_rd_base(lane);
    bf16x8 vf[4];
    switch (wave & 3) {
        case 0: GLA_FRAG(vf[0], vbase, 0, 0); GLA_FRAG(vf[1], vbase, 0, 1); GLA_FRAG(vf[2], vbase, 0, 2); GLA_FRAG(vf[3], vbase, 0, 3); break;
        case 1: GLA_FRAG(vf[0], vbase, 1, 0); GLA_FRAG(vf[1], vbase, 1, 1); GLA_FRAG(vf[2], vbase, 1, 2); GLA_FRAG(vf[3], vbase, 1, 3); break;
        case 2: GLA_FRAG(vf[0], vbase, 2, 0); GLA_FRAG(vf[1], vbase, 2, 1); GLA_FRAG(vf[2], vbase, 2, 2); GLA_FRAG(vf[3], vbase, 2, 3); break;
        default: GLA_FRAG(vf[0], vbase, 3, 0); GLA_FRAG(vf[1], vbase, 3, 1); GLA_FRAG(vf[2], vbase, 3, 2); GLA_FRAG(vf[3], vbase, 3, 3); break;
    }
    bf16_t* ob = dSt + ((size_t)unit * 256 + 32 * wave + r) * 128 + 8 * hh;
#define GA_KB(kb_) do { f32x16 acc = {}; bf16x8 kf; \
        GLA_FRAG(kf, kbase, kb_, 0); acc = __builtin_amdgcn_mfma_f32_32x32x16_bf16(kf, vf[0], acc, 0, 0, 0); GLA_FRAG(kf, kbase, kb_, 1); acc = __builtin_amdgcn_mfma_f32_32x32x16_bf16(kf, vf[1], acc, 0, 0, 0); \
        GLA_FRAG(kf, kbase, kb_, 2); acc = __builtin_amdgcn_mfma_f32_32x32x16_bf16(kf, vf[2], acc, 0, 0, 0); GLA_FRAG(kf, kbase, kb_, 3); acc = __builtin_amdgcn_mfma_f32_32x32x16_bf16(kf, vf[3], acc, 0, 0, 0); \
          \
        u32x2 w[4]; \
        _Pragma("unroll") for (int g4 = 0; g4 < 4; ++g4) { const f32x4 dk = *(const LAS f32x4*)(lds + L_BT + ((kb_) * 32 + 8 * g4 + 4 * hh) * 4); \
            w[g4].x = cvt_pk_bf16(acc[4 * g4] * dk[0], acc[4 * g4 + 1] * dk[1]); w[g4].y = cvt_pk_bf16(acc[4 * g4 + 2] * dk[2], acc[4 * g4 + 3] * dk[3]); } \
        _Pragma("unroll") for (int p = 0; p < 2; ++p) { auto rx = __builtin_amdgcn_permlane32_swap(w[2 * p].x, w[2 * p + 1].x, false, false); auto ry = __builtin_amdgcn_permlane32_swap(w[2 * p].y, w[2 * p + 1].y, false, false); \
            u32x4 o4 = {rx[0], ry[0], rx[1], ry[1]}; *(u32x4*)(ob + (kb_) * 32 + 16 * p) = o4; } } while (0)
    GA_KB(0); GA_KB(1); GA_KB(2); GA_KB(3);
#undef GA_KB
    __syncthreads();
}
__device__ __forceinline__ void gc_unit(LAS unsigned char* lds, int unit, const bf16_t* proj, const bf16_t* dSt, const float* gnorm, bf16_t* omix, int tid, int wave, int lane) {
    const int n = unit & 63, bh = unit >> 6, b = bh >> 3, h = bh & 7;
    const size_t row0 = (size_t)b * SEQ + n * 64;
    bf16x8 sfr[8];
    { const bf16_t* sp = dSt + ((size_t)unit * 256 + 32 * wave + (lane & 31)) * 128 + (lane >> 5) * 8;
#pragma unroll
      for (int ks = 0; ks < 8; ++ks) sfr[ks] = *(const bf16x8*)(sp + ks * 16); }
    { const int t = tid >> 3, c0 = (tid & 7) * 16; const bf16_t* qp = proj + (row0 + t) * PROJ_LD + C_GQ + h * 128 + c0;
      const u32x4 q0 = *(const u32x4*)qp, q1 = *(const u32x4*)(qp + 8), k0 = *(const u32x4*)(qp + (C_GK - C_GQ)), k1 = *(const u32x4*)(qp + (C_GK - C_GQ) + 8);
      u32x4 vr[4]; load_v(vr, proj + row0 * PROJ_LD + C_GV + h * 256, tid);
      *(LAS u32x4*)(lds + L_QD + t * 272 + c0 * 2) = q0; *(LAS u32x4*)(lds + L_QD + t * 272 + c0 * 2 + 16) = q1;
      *(LAS u32x4*)(lds + L_KI + t * 272 + c0 * 2) = k0; *(LAS u32x4*)(lds + L_KI + t * 272 + c0 * 2 + 16) = k1;
      store_v(lds, L_VT, vr, tid); }
    __syncthreads();
    const int r = lane & 31, hh = lane >> 5;
    if (wave < 4) { const int ct = wave & 1, st = wave >> 1; f32x16 acc = {};
#pragma unroll
        for (int ks = 0; ks < 8; ++ks) { const bf16x8 a = *(const LAS bf16x8*)(lds + L_QD + (ct * 32 + r) * 272 + ks * 32 + hh * 16), bb = *(const LAS bf16x8*)(lds + L_KI + (st * 32 + r) * 272 + ks * 32 + hh * 16);
            acc = __builtin_amdgcn_mfma_f32_32x32x16_bf16(a, bb, acc, 0, 0, 0); }
#pragma unroll
        for (int i = 0; i < 16; ++i) { const int c = ct * 32 + crow(i, hh), s2 = st * 32 + r; const float val = (s2 <= c) ? acc[i] : 0.f;
            *(LAS unsigned short*)(lds + L_AT + c * 144 + s2 * 2) = f2bf1(val); } }
    __syncthreads();
    f32x16 o0 = {}, o1 = {};
    { const int vbase = (int)(uintptr_t)(lds + L_VT + (wave >> 2) * 16384) + mb::v_rd_base(lane); bf16x8 vf[4];
      switch (wave & 3) {
          case 0: GLA_FRAG(vf[0], vbase, 0, 0); GLA_FRAG(vf[1], vbase, 0, 1); GLA_FRAG(vf[2], vbase, 0, 2); GLA_FRAG(vf[3], vbase, 0, 3); break;
          case 1: GLA_FRAG(vf[0], vbase, 1, 0); GLA_FRAG(vf[1], vbase, 1, 1); GLA_FRAG(vf[2], vbase, 1, 2); GLA_FRAG(vf[3], vbase, 1, 3); break;
          case 2: GLA_FRAG(vf[0], vbase, 2, 0); GLA_FRAG(vf[1], vbase, 2, 1); GLA_FRAG(vf[2], vbase, 2, 2); GLA_FRAG(vf[3], vbase, 2, 3); break;
          default: GLA_FRAG(vf[0], vbase, 3, 0); GLA_FRAG(vf[1], vbase, 3, 1); GLA_FRAG(vf[2], vbase, 3, 2); GLA_FRAG(vf[3], vbase, 3, 3); break;
      }
#pragma unroll
      for (int ss = 0; ss < 4; ++ss) { const bf16x8 a0 = *(const LAS bf16x8*)(lds + L_AT + r * 144 + ss * 32 + hh * 16), a1 = *(const LAS bf16x8*)(lds + L_AT + (32 + r) * 144 + ss * 32 + hh * 16);
          o0 = __builtin_amdgcn_mfma_f32_32x32x16_bf16(a0, vf[ss], o0, 0, 0, 0); o1 = __builtin_amdgcn_mfma_f32_32x32x16_bf16(a1, vf[ss], o1, 0, 0, 0); } }
    {
#pragma unroll
      for (int ks = 0; ks < 8; ++ks) { const bf16x8 bb = sfr[ks];
          const bf16x8 a0 = *(const LAS bf16x8*)(lds + L_QD + r * 272 + ks * 32 + hh * 16), a1 = *(const LAS bf16x8*)(lds + L_QD + (32 + r) * 272 + ks * 32 + hh * 16);
          o0 = __builtin_amdgcn_mfma_f32_32x32x16_bf16(a0, bb, o0, 0, 0, 0); o1 = __builtin_amdgcn_mfma_f32_32x32x16_bf16(a1, bb, o1, 0, 0, 0); } }
    __syncthreads();
#pragma unroll
    for (int i = 0; i < 16; ++i) { const int c = crow(i, hh); *(LAS float*)(lds + L_OT + c * 1040 + (32 * wave + r) * 4) = o0[i]; *(LAS float*)(lds + L_OT + (32 + c) * 1040 + (32 * wave + r) * 4) = o1[i]; }
    __syncthreads();
    const f32x4 g = *((const f32x4*)gnorm + lane);
#pragma unroll
    for (int rr = 0; rr < 8; ++rr) { const int c = 8 * wave + rr; const f32x4 v = *(const LAS f32x4*)(lds + L_OT + c * 1040 + lane * 16);
        float ss = (v[0] * v[0] + v[1] * v[1]) + (v[2] * v[2] + v[3] * v[3]);
#pragma unroll
        for (int o = 1; o < 64; o <<= 1) ss += __shfl_xor(ss, o);
        const float rs = 1.0f / sqrtf(ss * (1.0f / 256.0f) + EPS);
        const u32x2 gw2 = *((const u32x2*)(proj + (row0 + c) * PROJ_LD + C_GOUT + h * 256) + lane);
        const float z0 = bflo(gw2.x), z1 = bfhi(gw2.x), z2 = bflo(gw2.y), z3 = bfhi(gw2.y);
        const float p0 = v[0] * rs * g[0] * (z0 / (1.0f + __expf(-z0))), p1 = v[1] * rs * g[1] * (z1 / (1.0f + __expf(-z1)));
        const float p2 = v[2] * rs * g[2] * (z2 / (1.0f + __expf(-z2))), p3 = v[3] * rs * g[3] * (z3 / (1.0f + __expf(-z3)));
        u32x2 w; w.x = cvt_pk_bf16(p0, p1); w.y = cvt_pk_bf16(p2, p3); *((u32x2*)(omix + (row0 + c) * DM + h * 256) + lane) = w; }
    __syncthreads();
}
#undef GLA_FRAG
#undef GLA_TRRD
}

constexpr int NWAVES = 8;
constexpr int RING_BYTES = 131072;
constexpr int LDSCTL_OFF = 143360, MISC_OFF = LDSCTL_OFF + 320;
constexpr int LDS_BYTES = 147456;
constexpr int CW_BAR = 4096;
constexpr int NPHASE = 14;

typedef GAS unsigned gu32;
#define RLX_AGENT __ATOMIC_RELAXED, __HIP_MEMORY_SCOPE_AGENT
#define LDS_WAIT() asm volatile("s_waitcnt lgkmcnt(0)" ::: "memory")
#define VM_WAIT() asm volatile("s_waitcnt vmcnt(0)" ::: "memory")

#define XB_TMO      128
#define XB_XCNT(j)  (256  + 64 * (j))
#define XB_XSUB(j)  (1280 + 64 * (j))
#define XB_XGEN(j)  (2304 + 64 * (j))
#define XB_TOP      3328
#define XB_TOPGEN   3392
#define XCD_BAR_WORDS 3456
#define XB_SPIN_CAP (1u << 18)
__device__ __forceinline__ unsigned xb_ld(unsigned* p)              { return __hip_atomic_load(p, __ATOMIC_RELAXED, __HIP_MEMORY_SCOPE_AGENT); }
__device__ __forceinline__ unsigned xb_add(unsigned* p, unsigned v) { return __hip_atomic_fetch_add(p, v, __ATOMIC_RELAXED, __HIP_MEMORY_SCOPE_AGENT); }
__device__ __forceinline__ unsigned xb_xcc_id() { return (unsigned)__builtin_amdgcn_s_getreg((3 << 11) | 20) & 0xFu; }
#define XB_SPIN(cond, bar) do { unsigned _sp = 0; while (cond) { __builtin_amdgcn_s_sleep(1); \
    if ((++_sp & 255u) == 0u) { if (xb_ld(&(bar)[XB_TMO])) break; if (_sp > XB_SPIN_CAP) { atomicAdd(&(bar)[XB_TMO], 1u); break; } } } } while (0)
struct XcdBarrier { unsigned* bar; unsigned x; volatile LAS unsigned* st; };
__device__ __forceinline__ XcdBarrier xcd_barrier_post(unsigned* bar, volatile LAS unsigned* st) {
    XcdBarrier b; b.bar = bar; b.x = xb_xcc_id(); b.st = st;
    if (threadIdx.x == 0) (void)xb_add(&bar[XB_XCNT(b.x)], 1u);
    return b;
}
__device__ __forceinline__ void xcd_barrier_complete(unsigned* bar, unsigned x, unsigned& nloc, unsigned& nx) {
    const unsigned G = gridDim.x * gridDim.y * gridDim.z;
    unsigned sum, cnt, mine, sp = 0u;
    for (;;) {
        sum = 0u; cnt = 0u; mine = 0u;
#pragma unroll
        for (unsigned j = 0; j < 16; ++j) { const unsigned c = xb_ld(&bar[XB_XCNT(j)]); sum += c; cnt += (c > 0u) ? 1u : 0u; mine = (j == x) ? c : mine; }
        if (sum == G) break;
        __builtin_amdgcn_s_sleep(1);
        if ((++sp & 255u) == 0u) { if (xb_ld(&bar[XB_TMO])) break; if (sp > XB_SPIN_CAP) { atomicAdd(&bar[XB_TMO], 1u); break; } }
    }
    nloc = mine > 0u ? mine : 1u; nx = cnt > 0u ? cnt : 1u;
}
__device__ __forceinline__ void xcd_barrier(const XcdBarrier& b) {
    asm volatile("s_waitcnt vmcnt(0)" ::: "memory");
    __syncthreads();
    if (threadIdx.x == 0) {
        unsigned* bar = b.bar;
        __builtin_amdgcn_s_waitcnt(0);
        unsigned nloc = b.st[0], nx = b.st[1];
        if (nloc == 0u) { xcd_barrier_complete(bar, b.x, nloc, nx); b.st[0] = nloc; b.st[1] = nx; }
        const unsigned old = xb_add(&bar[XB_XSUB(b.x)], 1u);
        const unsigned gen = old / nloc;
        if (old + 1u == (gen + 1u) * nloc) {
            __builtin_amdgcn_fence(__ATOMIC_RELEASE, "agent");
            asm volatile("s_waitcnt vmcnt(0)" ::: "memory");
            const unsigned og = xb_add(&bar[XB_TOP], 1u);
            const unsigned tg = og / nx;
            if (og + 1u == (tg + 1u) * nx) xb_add(&bar[XB_TOPGEN], 1u);
            else XB_SPIN(xb_ld(&bar[XB_TOPGEN]) == tg, bar);
            __builtin_amdgcn_fence(__ATOMIC_ACQUIRE, "agent");
            xb_add(&bar[XB_XGEN(b.x)], 1u);
            asm volatile("s_waitcnt vmcnt(0)" ::: "memory");
        } else {
            XB_SPIN(xb_ld(&bar[XB_XGEN(b.x)]) == gen, bar);
            __builtin_amdgcn_fence(__ATOMIC_ACQUIRE, "agent");
            asm volatile("s_waitcnt vmcnt(0)" ::: "memory");
        }
    }
    __syncthreads();
}

struct Frame {
    LAS unsigned char* lds; char* ldsg;
    int tid, lane, wave, vcu, G;
    unsigned char* ws;
    float* out;
};
__device__ __forceinline__ float wave_sum(float v) {
#pragma unroll
    for (int o = 1; o < 64; o <<= 1) v += __shfl_xor(v, o);
    return v;
}
__device__ __forceinline__ void p0_transpose_item(const float* W, int ldw, int K, const float* gain, bf16_t* WT, int nblk, int ncol_src0, int row_off, LAS float* scr, int item, int lane) {
    const int kb = item / nblk, nb = item % nblk, k0 = 64 * kb, n0 = 32 * nb;
#pragma unroll 8
    for (int i = 0; i < 32; ++i) { const int kk = 2 * i + (lane >> 5); float w = W[(size_t)(k0 + kk) * ldw + ncol_src0 + n0 + (lane & 31)]; if (gain) w *= gain[k0 + kk]; scr[kk * 33 + (lane & 31)] = w; }
    LDS_WAIT(); asm volatile("" ::: "memory");
    const int c = lane & 7;
#pragma unroll
    for (int j = 0; j < 4; ++j) { const int n = (lane >> 3) + 8 * j; const LAS float* s = scr + (8 * c) * 33 + n;
        u32x4 o; o.x = cvt_pk_bf16(s[0 * 33], s[1 * 33]); o.y = cvt_pk_bf16(s[2 * 33], s[3 * 33]); o.z = cvt_pk_bf16(s[4 * 33], s[5 * 33]); o.w = cvt_pk_bf16(s[6 * 33], s[7 * 33]);
        *(GAS u32x4*)(WT + (size_t)(row_off + n0 + n) * K + k0 + 8 * c) = o; }
    LDS_WAIT(); asm volatile("" ::: "memory");
}

__device__ __forceinline__ mb::BlockRef moba_ref(const bf16_t* qkvh, bf16_t* omix, const float* kmean, int Li, int pass) {
    mb::BlockRef r; const int bh = Li >> 3, xx = Li & 7, b = bh >> 4, h = bh & 15; const int qb = pass ? 15 - xx : xx;
    const bf16_t* base = qkvh + (size_t)bh * SEQ * 128;
    r.Q = base + (size_t)(qb * 256) * 128; r.K = base + QKVH_T; r.V = base + 2 * QKVH_T; r.O = omix + (size_t)(b * SEQ + qb * 256) * DM + 2048 + h * 128; r.km = kmean + (size_t)bh * 2048; r.qb = qb; return r;
}
__device__ __forceinline__ void p0_transpose64(const float* W, int ldw, int K, const float* gain, bf16_t* WT, int nblk, int ncol_src0, int row_off, LAS float* scr, int item, int lane) {
    const int kb = item / nblk, nb = item % nblk, k0 = 64 * kb, n0 = 64 * nb;
    const int c4 = (lane & 15) * 4, kr = lane >> 4;
    f32x4 w[16];
#pragma unroll
    for (int i = 0; i < 16; ++i) w[i] = __builtin_nontemporal_load((const f32x4*)(W + (size_t)(k0 + kr + 4 * i) * ldw + ncol_src0 + n0 + c4));
#pragma unroll
    for (int i = 0; i < 16; ++i) { f32x4 v = w[i]; if (gain) v = v * gain[k0 + kr + 4 * i]; *(LAS f32x4*)(scr + (kr + 4 * i) * 68 + c4) = v; }
    LDS_WAIT(); asm volatile("" ::: "memory");
#pragma unroll
    for (int j = 0; j < 8; ++j) { const int idx = lane + 64 * j, n = idx >> 3, c = idx & 7; const LAS float* sp = scr + (8 * c) * 68 + n;
        u32x4 o; o.x = cvt_pk_bf16(sp[0 * 68], sp[1 * 68]); o.y = cvt_pk_bf16(sp[2 * 68], sp[3 * 68]); o.z = cvt_pk_bf16(sp[4 * 68], sp[5 * 68]); o.w = cvt_pk_bf16(sp[6 * 68], sp[7 * 68]);
        *(GAS u32x4*)(WT + (size_t)(row_off + n0 + n) * K + k0 + 8 * c) = o; }
    LDS_WAIT(); asm volatile("" ::: "memory");
}
struct P0Item { const float* src; const float* gain; bf16_t* dst; int ldw, K; };
__device__ __forceinline__ P0Item p0_item(const float* W, int ldw, int K, const float* gain, bf16_t* WT, int nblk, int ncol_src0, int row_off, int item) {
    const int kb = item / nblk, nb = item % nblk, k0 = 64 * kb, n0 = 64 * nb; P0Item r;
    r.src = W + (size_t)k0 * ldw + ncol_src0 + n0; r.gain = gain ? gain + k0 : nullptr; r.dst = WT + (size_t)(row_off + n0) * K + k0; r.ldw = ldw; r.K = K; return r; }
__device__ __forceinline__ void p0_load(const P0Item& it, f32x4 (&w)[16], int lane) {
    const unsigned voff = (unsigned)(((lane >> 4) * it.ldw + (lane & 15) * 4) * 4);
#pragma unroll
    for (int i = 0; i < 16; ++i) w[i] = __builtin_nontemporal_load((const f32x4*)((const char*)(it.src + (size_t)(4 * i) * it.ldw) + voff));
}
__device__ __forceinline__ void p0_finish(const P0Item& it, const f32x4 (&w)[16], LAS float* scr, int lane) {
    const int c4 = (lane & 15) * 4, kr = lane >> 4;
    if (it.gain) { const unsigned goff = (unsigned)(kr * 4);
#pragma unroll
        for (int i = 0; i < 16; ++i) { const float g = *(const float*)((const char*)(it.gain + 4 * i) + goff); *(LAS f32x4*)(scr + (kr + 4 * i) * 68 + c4) = w[i] * g; } }
    else {
#pragma unroll
        for (int i = 0; i < 16; ++i) *(LAS f32x4*)(scr + (kr + 4 * i) * 68 + c4) = w[i]; }
    LDS_WAIT(); asm volatile("" ::: "memory");
    const unsigned soff = (unsigned)(((lane >> 3) * it.K + 8 * (lane & 7)) * 2);
#pragma unroll
    for (int j = 0; j < 8; ++j) { const int n = (lane >> 3) + 8 * j, c = lane & 7; const LAS float* sp = scr + (8 * c) * 68 + n;
        u32x4 o; o.x = cvt_pk_bf16(sp[0 * 68], sp[1 * 68]); o.y = cvt_pk_bf16(sp[2 * 68], sp[3 * 68]); o.z = cvt_pk_bf16(sp[4 * 68], sp[5 * 68]); o.w = cvt_pk_bf16(sp[6 * 68], sp[7 * 68]);
        *(GAS u32x4*)((char*)(it.dst + (size_t)(8 * j) * it.K) + soff) = o; }
    LDS_WAIT(); asm volatile("" ::: "memory");
}
template <class F> __device__ __forceinline__ void p0_pipe(int n, F desc, LAS float* scr, int lane) {
    P0Item a = desc(0), b = a; f32x4 w0[16], w1[16];
    p0_load(a, w0, lane);
    for (int j = 0; j < n; j += 2) {
        const bool hb_ = j + 1 < n; if (hb_) { b = desc(j + 1); p0_load(b, w1, lane); }
        p0_finish(a, w0, scr, lane);
        if (!hb_) break;
        if (j + 2 < n) { a = desc(j + 2); p0_load(a, w0, lane); }
        p0_finish(b, w1, scr, lane);
    }
}
__device__ __forceinline__ float absmax8(const u32x4 (&w)[8]) { float mx = 0.f;
#pragma unroll
    for (int j = 0; j < 8; ++j) mx = fmaxf(mx, fmaxf(fmaxf(fmaxf(fabsf(bflo(w[j].x)), fabsf(bfhi(w[j].x))), fmaxf(fabsf(bflo(w[j].y)), fabsf(bfhi(w[j].y)))), fmaxf(fmaxf(fabsf(bflo(w[j].z)), fabsf(bfhi(w[j].z))), fmaxf(fabsf(bflo(w[j].w)), fabsf(bfhi(w[j].w))))));
#pragma unroll
    for (int o = 1; o < 64; o <<= 1) mx = fmaxf(mx, __shfl_xor(mx, o));
    return mx; }
__device__ __forceinline__ void quant_store8(const u32x4 (&w)[8], float inv, signed char* dst, int lane) { u32x2* qp = (u32x2*)dst + lane;
#pragma unroll
    for (int j = 0; j < 8; ++j) { const unsigned ww[4] = {w[j].x, w[j].y, w[j].z, w[j].w}; unsigned o2[2];
#pragma unroll
        for (int h2 = 0; h2 < 2; ++h2) { const int q0 = (int)rintf(bflo(ww[2 * h2]) * inv), q1 = (int)rintf(bfhi(ww[2 * h2]) * inv), q2 = (int)rintf(bflo(ww[2 * h2 + 1]) * inv), q3 = (int)rintf(bfhi(ww[2 * h2 + 1]) * inv);
            o2[h2] = (unsigned)(q0 & 255) | ((unsigned)(q1 & 255) << 8) | ((unsigned)(q2 & 255) << 16) | ((unsigned)(q3 & 255) << 24); }
        u32x2 o; o.x = o2[0]; o.y = o2[1]; qp[64 * j] = o; } }
__device__ __forceinline__ void quant_rows2(const bf16_t* s0, const bf16_t* s1, signed char* d0, signed char* d1, int lane, float& step0, float& step1) {
    const u32x4* p0 = (const u32x4*)s0 + lane; const u32x4* p1 = (const u32x4*)s1 + lane; u32x4 w0[8], w1[8];
#pragma unroll
    for (int j = 0; j < 8; ++j) { w0[j] = p0[64 * j]; w1[j] = p1[64 * j]; }
    step0 = fmaxf(absmax8(w0), 1e-30f) * (1.0f / 127.0f); step1 = fmaxf(absmax8(w1), 1e-30f) * (1.0f / 127.0f);
    quant_store8(w0, 1.0f / step0, d0, lane); quant_store8(w1, 1.0f / step1, d1, lane);
}
template <bool U8> __device__ __forceinline__ void rot_load(u32x4 (&w)[8], float (&st)[4], const void* src, const float* steps, int tl) {
    if (U8) {
#pragma unroll
        for (int j = 0; j < 4; ++j) { const int p = j * 256 + tl; w[j] = __builtin_nontemporal_load((const u32x4*)src + p); st[j] = steps[(p >> 4) * 4 + ((p & 7) >> 1)]; }
    } else {
#pragma unroll
        for (int j = 0; j < 4; ++j) { const int p = j * 256 + tl; w[2 * j] = __builtin_nontemporal_load((const u32x4*)src + 2 * p); w[2 * j + 1] = __builtin_nontemporal_load((const u32x4*)src + 2 * p + 1); }
    }
}
template <bool CENTER, bool U8>
__device__ __forceinline__ void rot_finish(const u32x4 (&w)[8], const float (&st)[4], signed char* dst, LAS float* red, int tl, int half, int wv4, int lane, float& step_out, float& sum_out) {
    f32x2 pr[32];
    if (U8) {
#pragma unroll
        for (int j = 0; j < 4; ++j) { const unsigned ww[4] = {w[j].x, w[j].y, w[j].z, w[j].w};
#pragma unroll
            for (int d = 0; d < 4; ++d) { f32x2 ra = {(float)(ww[d] & 255u), (float)((ww[d] >> 8) & 255u)}, rb = {(float)((ww[d] >> 16) & 255u), (float)(ww[d] >> 24)};
                ra = ra * st[j]; rb = rb * st[j]; pr[8 * j + 2 * d] = ra * ra; pr[8 * j + 2 * d + 1] = rb * rb; } }
    } else {
#pragma unroll
        for (int j = 0; j < 8; ++j) { pr[4 * j] = (f32x2){bflo(w[j].x), bfhi(w[j].x)}; pr[4 * j + 1] = (f32x2){bflo(w[j].y), bfhi(w[j].y)}; pr[4 * j + 2] = (f32x2){bflo(w[j].z), bfhi(w[j].z)}; pr[4 * j + 3] = (f32x2){bflo(w[j].w), bfhi(w[j].w)}; }
    }
#pragma unroll
    for (int i = 0; i < 32; ++i) { const float a = pr[i][0], b = pr[i][1]; pr[i] = (f32x2){a + b, a - b}; }
#pragma unroll
    for (int h = 1; h < 32; h <<= 1)
#pragma unroll
        for (int i = 0; i < 32; ++i) if (!(i & h)) { const f32x2 a = pr[i], b = pr[i + h]; pr[i] = a + b; pr[i + h] = a - b; }
    float sm = pr[0][0];
#pragma unroll
    for (int o = 1; o < 64; o <<= 1) sm += __shfl_xor(sm, o);
    float mx = 0.f;
    if (CENTER) {
        if (lane == 0) red[half * 4 + wv4] = sm;
        __syncthreads();
        sm = (red[half * 4] + red[half * 4 + 1]) + (red[half * 4 + 2] + red[half * 4 + 3]);
        pr[0][0] -= sm * (64.0f / DFF);
    }
#pragma unroll
    for (int i = 0; i < 32; ++i) mx = fmaxf(mx, fmaxf(fabsf(pr[i][0]), fabsf(pr[i][1])));
#pragma unroll
    for (int o = 1; o < 64; o <<= 1) mx = fmaxf(mx, __shfl_xor(mx, o));
    if (lane == 0) { red[16 + half * 4 + wv4] = mx; if (!CENTER) red[half * 4 + wv4] = sm; }
    __syncthreads();
    mx = fmaxf(fmaxf(red[16 + half * 4], red[16 + half * 4 + 1]), fmaxf(red[16 + half * 4 + 2], red[16 + half * 4 + 3]));
    if (!CENTER) sm = (red[half * 4] + red[half * 4 + 1]) + (red[half * 4 + 2] + red[half * 4 + 3]);
    const float step = fmaxf(mx, 1e-30f) * (1.0f / 127.0f), inv = 1.0f / step;
#pragma unroll
    for (int jj = 0; jj < 4; ++jj) { unsigned o4[4];
#pragma unroll
        for (int d = 0; d < 4; ++d) { const f32x2 a = pr[8 * jj + 2 * d] * inv + 128.0f, b = pr[8 * jj + 2 * d + 1] * inv + 128.0f;
            unsigned q = __builtin_amdgcn_cvt_pk_u8_f32(rintf(a[0]), 0, 0u); q = __builtin_amdgcn_cvt_pk_u8_f32(rintf(a[1]), 1, q); q = __builtin_amdgcn_cvt_pk_u8_f32(rintf(b[0]), 2, q); q = __builtin_amdgcn_cvt_pk_u8_f32(rintf(b[1]), 3, q);
            o4[d] = q ^ 0x80808080u; }
        u32x4 o; o.x = o4[0]; o.y = o4[1]; o.z = o4[2]; o.w = o4[3]; *((u32x4*)dst + jj * 256 + tl) = o; }
    step_out = step; sum_out = sm;
    __syncthreads();
}
template <bool CENTER, bool U8, class Fin>
__device__ __forceinline__ void rot_rows(const unsigned char* src, size_t src_ld_bytes, const float* steps, signed char* dst, int row0, int n, LAS float* red, int tl, int half, int wv4, int lane, Fin fin) {
    u32x4 wa[8], wb[8]; float sa[4] = {0.f, 0.f, 0.f, 0.f}, sb[4] = {0.f, 0.f, 0.f, 0.f}; float st, sm;
    rot_load<U8>(wa, sa, src + (size_t)(row0 + half) * src_ld_bytes, steps + (size_t)(row0 + half) * 256, tl);
    for (int it = 0; it < n; it += 2) {
        const int ra = row0 + 2 * it + half, rb = ra + 2;
        rot_load<U8>(wb, sb, src + (size_t)rb * src_ld_bytes, steps + (size_t)rb * 256, tl);
        rot_finish<CENTER, U8>(wa, sa, dst + (size_t)ra * RQ_LD, red, tl, half, wv4, lane, st, sm); if (tl == 0) fin(ra, st, sm);
        if (it + 2 < n) rot_load<U8>(wa, sa, src + (size_t)(rb + 2) * src_ld_bytes, steps + (size_t)(rb + 2) * 256, tl);
        rot_finish<CENTER, U8>(wb, sb, dst + (size_t)rb * RQ_LD, red, tl, half, wv4, lane, st, sm); if (tl == 0) fin(rb, st, sm);
    }
}
struct Args { const float* in[18]; float* out; unsigned char* ws; int ph_lo, ph_hi; };
__global__ void __launch_bounds__(NWAVES * 64, 2) fwd(Args args) {
    extern __shared__ __attribute__((aligned(16))) unsigned char lds[];
    Frame F;
    F.lds = (LAS unsigned char*)lds; F.ldsg = (char*)lds;
    F.tid = threadIdx.x; F.lane = F.tid & 63; F.wave = __builtin_amdgcn_readfirstlane(F.tid >> 6);
    F.G = gridDim.x; { const int bx = blockIdx.x; F.vcu = (F.G % 8 == 0) ? (bx % 8) * (F.G / 8) + bx / 8 : bx; }
    F.ws = args.ws; F.out = args.out;
    unsigned char* ws = args.ws;
    volatile LAS unsigned* MISC = (volatile LAS unsigned*)(F.lds + MISC_OFF);
    for (int u = F.tid; u < (LDS_BYTES - LDSCTL_OFF) / 4; u += NWAVES * 64) ((LAS unsigned*)(F.lds + LDSCTL_OFF))[u] = 0u;
    __syncthreads();
    XcdBarrier bar; bar.bar = (unsigned*)(ws + WS_CTL) + CW_BAR; bar.x = 0; bar.st = nullptr;
    if (MK_ONE_LAUNCH) bar = xcd_barrier_post((unsigned*)(ws + WS_CTL) + CW_BAR, MISC + 8);
    const int lo = args.ph_lo, hi = args.ph_hi;
#ifndef PH_MASK
#define PH_MASK 0xFFFF
#endif
#define IN(k) (((PH_MASK >> (k)) & 1) && lo <= (k) && (k) < hi)
#define SEAM(k) do { if (IN(k) && IN((k) + 1)) xcd_barrier(bar); } while (0)

#define ARGP(k) (((const float* const volatile*)((const Args*)__builtin_amdgcn_kernarg_segment_ptr())->in)[k])
#define in_x ARGP(0)
#define in_mem ARGP(1)
#define g_mix ARGP(2)
#define w_in ARGP(3)
#define w_gate_up ARGP(4)
#define b_gate ARGP(5)
#define gla_norm_g ARGP(6)
#define w_out ARGP(7)
#define g_cross ARGP(8)
#define g_mem ARGP(9)
#define w_cq ARGP(10)
#define w_ck ARGP(11)
#define w_cv ARGP(12)
#define w_co ARGP(13)
#define g_mlp ARGP(14)
#define w_up ARGP(15)
#define w_down ARGP(16)
#define g_final ARGP(17)
    float* rstd_x = (float*)(ws + WS_RSTDX); float* colq = (float*)(ws + WS_RSTD1); float* rowq = (float*)(ws + WS_RSTD2);
    signed char* W_upq = (signed char*)F.out + 128 * MiB; signed char* hq = (signed char*)F.out + 192 * MiB;
    float* colq_up = (float*)(ws + WS_WGLOW + 262144); float* rowq2 = (float*)(ws + WS_WGLOW + 393216);
    float* r8s = (float*)(ws + WS_R8S); signed char* uq = (signed char*)(ws + WS_UQ); signed char* Wdq = (signed char*)(ws + WS_WDQ);
    float* sw_dn = (float*)(ws + WS_WGLOW + 524288); float* cw_dn = sw_dn + 4096; float* sa_u = cw_dn + 4096; float* m_u = sa_u + T;
    signed char* xq = (signed char*)(ws + WS_OMIX); signed char* W_inq = (signed char*)(ws + WS_OMIX + 64 * MiB);
    float* ropec = (float*)(ws + WS_ROPEC); float* ropes = (float*)(ws + WS_ROPES); float* kmean = (float*)(ws + WS_KMEAN);
    float* glow = (float*)(ws + WS_GLOW); float* part = (float*)(ws + WS_PART);
    bf16_t* W_inT = (bf16_t*)(ws + WS_WIN); bf16_t* W_outT = (bf16_t*)(ws + WS_WOUT); bf16_t* W_ckvT = (bf16_t*)(ws + WS_WCKV); bf16_t* W_cqb = (bf16_t*)(ws + WS_WCQ);
    bf16_t* W_coT = (bf16_t*)(ws + WS_WCO); bf16_t* W_upT = (bf16_t*)(ws + WS_WUP); bf16_t* W_dnT = (bf16_t*)(ws + WS_WDN);
    bf16_t* WqkT = (bf16_t*)(ws + WS_WQK); bf16_t* WvoT = (bf16_t*)(ws + WS_WVO); bf16_t* kcvc = (bf16_t*)(ws + WS_KCVC); bf16_t* memn = (bf16_t*)(ws + WS_MEMN);
    bf16_t* hb = (bf16_t*)(ws + WS_HB); bf16_t* proj = (bf16_t*)(ws + WS_PROJ); bf16_t* qkvh = (bf16_t*)(ws + WS_QKVH); bf16_t* omix = (bf16_t*)(ws + WS_OMIX); bf16_t* Pm = (bf16_t*)(ws + WS_P); bf16_t* Ub = (bf16_t*)(ws + WS_U);
    bf16_t* dSt = (bf16_t*)F.out;
    float* decay = (float*)(ws + WS_DECAY); bf16_t* W_glowT = (bf16_t*)(ws + WS_WGLOW);
    const int gw = F.vcu * NWAVES + F.wave, NGW = F.G * NWAVES;

    constexpr int NQB = (IN_N - IN_Q0) / 64;
    static_assert(NQB <= 200, "P0 needs some workgroups without an int8 in-projection block");
    if (IN(0)) {
        LAS float* scr = (LAS float*)(F.lds + F.wave * 17408);
        const int bx = (int)blockIdx.x;
        if (bx < NQB) {
            const int nb = IN_Q0 / 64 + bx, src0 = (nb * 64 >= 4096) ? 16 : 0;
            { const float* wsrc = w_in; const float* gsrc = g_mix; const int wv = F.wave;
              p0_pipe(8, [&](int i) { return p0_item(wsrc, INW, DM, gsrc, W_inT, IN_N / 64, src0, 0, (wv + 8 * i) * (IN_N / 64) + nb); }, scr, F.lane); }
            VM_WAIT(); __syncthreads();
            for (int p = 0; p < 4; ++p) { const int n = 64 * bx + 8 * F.wave + 2 * p; float s0, s1;
                quant_rows2(W_inT + (size_t)(IN_Q0 + n) * DM, W_inT + (size_t)(IN_Q0 + n + 1) * DM, W_inq + (size_t)n * DM, W_inq + (size_t)(n + 1) * DM, F.lane, s0, s1);
                if (F.lane == 0) { colq[n] = s0; colq[n + 1] = s1; } }
        } else {
            constexpr int I_INL = (DM / 64) * (IN_Q0 / 64);
            for (int it = (bx - NQB) * NWAVES + F.wave; it < I_INL; it += (256 - NQB) * NWAVES) { const int kb = it / (IN_Q0 / 64), nb = it % (IN_Q0 / 64);
                p0_transpose64(w_in, INW, DM, g_mix, W_inT, IN_N / 64, (nb * 64 >= 4096) ? 16 : 0, 0, scr, kb * (IN_N / 64) + nb, F.lane); }
        }
        { int m, mstep, mcnt;
          if (bx < NQB) { m = bx * 48 + F.wave * 6; mstep = 1; mcnt = 6; } else { m = NQB * 48 + (bx - NQB) * NWAVES + F.wave; mstep = (256 - NQB) * NWAVES; mcnt = T; }
          for (int j = 0; j < mcnt && m < T; ++j, m += mstep) {
            const f32x4* xr = (const f32x4*)(in_x + (size_t)m * DM) + F.lane; f32x4 v[16]; float s2 = 0.f;
#pragma unroll
            for (int j2 = 0; j2 < 16; ++j2) { v[j2] = __builtin_nontemporal_load(xr + 64 * j2); s2 += (v[j2][0] * v[j2][0] + v[j2][1] * v[j2][1]) + (v[j2][2] * v[j2][2] + v[j2][3] * v[j2][3]); }
            const float rs = 1.0f / sqrtf(wave_sum(s2) * (1.0f / DM) + EPS);
            float mx = 0.f;
#pragma unroll
            for (int j2 = 0; j2 < 16; ++j2) mx = fmaxf(fmaxf(mx, fmaxf(fabsf(v[j2][0]), fabsf(v[j2][1]))), fmaxf(fabsf(v[j2][2]), fabsf(v[j2][3])));
#pragma unroll
            for (int o = 1; o < 64; o <<= 1) mx = fmaxf(mx, __shfl_xor(mx, o));
            const float step = fmaxf(mx, 1e-30f) * (1.0f / 127.0f), inv = 1.0f / step;
            if (F.lane == 0) { rstd_x[m] = rs; rowq[m] = rs * step; }
            u32x2* o8 = (u32x2*)(hb + (size_t)m * DM) + F.lane; unsigned* q4 = (unsigned*)(xq + (size_t)m * DM) + F.lane;
#pragma unroll
            for (int j2 = 0; j2 < 16; ++j2) { u32x2 w; w.x = cvt_pk_bf16(v[j2][0], v[j2][1]); w.y = cvt_pk_bf16(v[j2][2], v[j2][3]); o8[64 * j2] = w;
                const int q0 = (int)rintf(v[j2][0] * inv), q1 = (int)rintf(v[j2][1] * inv), q2 = (int)rintf(v[j2][2] * inv), q3 = (int)rintf(v[j2][3] * inv);
                q4[64 * j2] = (unsigned)(q0 & 255) | ((unsigned)(q1 & 255) << 8) | ((unsigned)(q2 & 255) << 16) | ((unsigned)(q3 & 255) << 24); }
          } }
        for (int m = gw; m < TM; m += NGW) {
            const f32x4* xr = (const f32x4*)(in_mem + (size_t)m * DM) + F.lane; f32x4 v[16]; float s2 = 0.f;
#pragma unroll
            for (int j = 0; j < 16; ++j) { v[j] = xr[64 * j]; s2 += (v[j][0] * v[j][0] + v[j][1] * v[j][1]) + (v[j][2] * v[j][2] + v[j][3] * v[j][3]); }
            const float rs = 1.0f / sqrtf(wave_sum(s2) * (1.0f / DM) + EPS);
            u32x2* o8 = (u32x2*)(memn + (size_t)m * DM) + F.lane;
#pragma unroll
            for (int j = 0; j < 16; ++j) { const f32x4 g = *((const f32x4*)g_mem + F.lane + 64 * j); u32x2 w; w.x = cvt_pk_bf16(v[j][0] * rs * g[0], v[j][1] * rs * g[1]); w.y = cvt_pk_bf16(v[j][2] * rs * g[2], v[j][3] * rs * g[3]); o8[64 * j] = w; }
        }
        for (int e = gw * 64 + F.lane; e < SEQ * 16; e += NGW * 64) { const int pos = e >> 4, i = e & 15;
            const float inv_freq = powf(500000.0f, -(float)i * (1.0f / 16.0f)); const float ang = (float)pos * inv_freq;
            ropec[e] = cosf(ang); ropes[e] = sinf(ang);
            const int n = e >> 12, kk = e & 4095; W_glowT[e] = gla::f2bf1(w_in[(size_t)kk * INW + 4096 + n] * g_mix[kk]); }
    }
    SEAM(0);

    if (IN(2)) {
        const int slot = ((int)blockIdx.x & 63) % 3;
#define P2_SLICE() do {                                                                                                                                                             \
        int ln_ = F.lane, wv_ = F.wave, bx_ = (int)blockIdx.x; asm volatile("" : "+v"(ln_)); asm volatile("" : "+s"(wv_)); asm volatile("" : "+s"(bx_));     \
        const int ln = ln_, wv = wv_, bx = bx_; LAS float* scr = (LAS float*)(F.lds + wv * 17408);                                                                                      \
                                                                                           \
        { const float* wsrc = w_up; const float* gsrc = g_mlp;                                                                                               \
          p0_pipe(8, [&](int i) { return p0_item(wsrc, DFF, DM, gsrc, W_upT, DFF / 64, 0, 0, (wv + 8 * i) * (DFF / 64) + bx); }, scr, ln); }                                     \
        VM_WAIT(); __syncthreads();                                                                                                                                                 \
        for (int p = 0; p < 4; ++p) { const int n = 64 * bx + 8 * wv + 2 * p; float s0, s1;                                                                                     \
            quant_rows2(W_upT + (size_t)n * DM, W_upT + (size_t)(n + 1) * DM, W_upq + (size_t)n * DM, W_upq + (size_t)(n + 1) * DM, ln, s0, s1);                                \
            if (ln == 0) { colq_up[n] = s0; colq_up[n + 1] = s1; } }                                                                                                            \
                                         \
        { constexpr int I_SQ = (DM / 64) * (DM / 64), I_DN = (DFF / 64) * (DM / 64); static_assert(4 * I_SQ + I_DN == 256 * 128, "generic weight items");                            \
          const float* s_out = w_out; const float* s_ck = w_ck; const float* s_cv = w_cv; const float* s_co = w_co; const float* s_dn = w_down; const int it0 = bx * 128 + wv;   \
          p0_pipe(16, [&](int i) { int r = it0 + 8 * i;                                                                                                                             \
              if (r < I_SQ) return p0_item(s_out, DM, DM, nullptr, W_outT, DM / 64, 0, 0, r); r -= I_SQ;                                                                            \
              if (r < I_SQ) return p0_item(s_ck, DM, DM, nullptr, W_ckvT, DM / 64, 0, 0, r); r -= I_SQ;                                                                             \
              if (r < I_SQ) return p0_item(s_cv, DM, DM, nullptr, W_ckvT, DM / 64, 0, DM, r); r -= I_SQ;                                                                            \
              if (r < I_SQ) return p0_item(s_co, DM, DM, nullptr, W_coT, DM / 64, 0, 0, r); r -= I_SQ;                                                                              \
              return p0_item(s_dn, DM, DFF, nullptr, W_dnT, DM / 64, 0, 0, r); }, scr, ln);                                                                                     \
          for (int q = 0; q < 2; ++q) {                                                                                      \
              const int kk = bx * 16 + wv * 2 + q; const float g = g_cross[kk]; const f32x4* src = (const f32x4*)(w_cq + (size_t)kk * DM) + ln; u32x2* dst = (u32x2*)(W_cqb + (size_t)kk * DM) + ln;   \
              _Pragma("unroll") for (int j = 0; j < 16; ++j) { const f32x4 v = __builtin_nontemporal_load(src + 64 * j); u32x2 w; w.x = cvt_pk_bf16(v[0] * g, v[1] * g); w.y = cvt_pk_bf16(v[2] * g, v[3] * g); dst[64 * j] = w; } } }   \
                                                               \
        { const int it = F.vcu * NWAVES + wv, grp = it >> 1, kh = it & 1, i = ln & 15, kq = ln >> 4;                                                                    \
            const bf16_t* ap = hb + (size_t)(grp * 16 + i) * DM + kh * 2048 + kq * 8; const bf16_t* bp = W_glowT + (size_t)i * DM + kh * 2048 + kq * 8;                             \
            f32x4 acc = {0.f, 0.f, 0.f, 0.f};                                                                                                                                       \
            _Pragma("unroll 8") for (int k0 = 0; k0 < 2048; k0 += 32) acc = __builtin_amdgcn_mfma_f32_16x16x32_bf16(*(const bf16x8*)(ap + k0), *(const bf16x8*)(bp + k0), acc, 0, 0, 0);   \
            __syncthreads();                                                                                                                                                        \
            LAS f32x4* xch = (LAS f32x4*)F.lds + (wv >> 1) * 64 + ln;                                                                                                       \
            if (kh == 1) *xch = acc;                                                                                                                                                \
            __syncthreads();                                                                                                                                                        \
            if (kh == 0) { acc = acc + *xch;                                                                                                                                        \
                _Pragma("unroll") for (int r = 0; r < 4; ++r) { const int row = grp * 16 + 4 * kq + r; glow[(size_t)row * 16 + i] = acc[r] * rstd_x[row]; } } }                     \
        VM_WAIT(); __syncthreads(); } while (0)
        if (slot == 0) P2_SLICE();
        { pg8::StdPtrs P{(const char*)hb, (const char*)W_inT, DM, DM, DM, 0, 0}; pg8::StaticOrder S; S.init(T, IN_Q0, F.G, (int)blockIdx.x);
          pg8::EpiBf16<0> E{proj, PROJ_LD, rstd_x};
          pg8::gemm_phase<pg8::EpiBf16<0>, pg8::StaticOrder, pg8::StdPtrs, true>(F.lds, P, S, E); }
        if (slot == 1) P2_SLICE();
        { pg8::StdPtrs P{(const char*)xq, (const char*)W_inq, DM / 2, DM / 2, DM / 2, 0, 0}; pg8::StaticOrder S; S.init(T, IN_N - IN_Q0, F.G, (int)blockIdx.x);
          pg8::EpiProjMoba E{proj, qkvh, rowq, colq, ropec, ropes, IN_Q0 / 256};
          pg8::gemm_phase<pg8::EpiProjMoba, pg8::StaticOrder, pg8::StdPtrs, true, true>(F.lds, P, S, E); }
        if (slot == 2) P2_SLICE();
#undef P2_SLICE
    }
    SEAM(2);

    if (IN(3)) {
        for (int it = gw; it < 64 * 16; it += NGW) {
            const int bh = it >> 4, blk = it & 15, b = bh >> 4, h = bh & 15, rsub = F.lane >> 4, c8 = (F.lane & 15) * 8;
            const bf16_t* kp = qkvh + QKVH_T + ((size_t)bh * SEQ + blk * 256 + rsub) * 128 + c8; float a[8];
#pragma unroll
            for (int j = 0; j < 8; ++j) a[j] = 0.f;
#pragma unroll 16
            for (int r = 0; r < 64; ++r) { const u32x4 w = *(const u32x4*)(kp + (size_t)(4 * r) * 128);
                a[0] += bflo(w.x); a[1] += bfhi(w.x); a[2] += bflo(w.y); a[3] += bfhi(w.y); a[4] += bflo(w.z); a[5] += bfhi(w.z); a[6] += bflo(w.w); a[7] += bfhi(w.w); }
#pragma unroll
            for (int j = 0; j < 8; ++j) { a[j] += __shfl_xor(a[j], 16); a[j] += __shfl_xor(a[j], 32); a[j] *= (1.0f / 256.0f); }
            if (rsub == 0) { float* o = kmean + (size_t)it * 128 + c8; *(f32x4*)o = (f32x4){a[0], a[1], a[2], a[3]}; *(f32x4*)(o + 4) = (f32x4){a[4], a[5], a[6], a[7]}; }
        }
        VM_WAIT(); __syncthreads();
        { pg8::StdPtrs P{(const char*)memn, (const char*)W_ckvT, DM, DM, DM, 0, 0}; pg8::StaticOrder S; S.init(TM, 2 * DM, F.G, (int)blockIdx.x);
          pg8::EpiBf16<0> E{kcvc, 2 * DM, nullptr};
          pg8::gemm_phase<pg8::EpiBf16<0>, pg8::StaticOrder, pg8::StdPtrs, true>(F.lds, P, S, E); }
        { const int bx = (int)blockIdx.x; int u0, nu;
          if (bx < 128) { u0 = bx * 4; nu = 4; } else { u0 = 512 + (bx - 128) * 12; nu = 12; }
          for (int j = 0; j < nu; ++j) gla::ga_unit(F.lds, u0 + j, proj, glow, w_gate_up, b_gate, dSt, decay, F.tid, F.wave, F.lane); }
    }
    SEAM(3);

    if (IN(4)) {
        for (int e = (F.vcu * NWAVES * 64) + F.tid; e < 32 * 256 * 16; e += F.G * NWAVES * 64) {
            const int bh = e >> 12, rem = e & 4095, v = rem >> 4, kg = rem & 15;
            u32x4* p = (u32x4*)(dSt + ((size_t)(bh * 64) * 256 + v) * 128 + kg * 8);
            const f32x4* dp = (const f32x4*)(decay + (size_t)bh * 64 * 128 + kg * 8);
            float st[8];
#pragma unroll
            for (int j = 0; j < 8; ++j) st[j] = 0.f;
#pragma unroll 8
            for (int n = 0; n < 64; ++n) { const u32x4 w = p[(size_t)n * 4096]; const f32x4 d0 = dp[n * 32], d1 = dp[n * 32 + 1];
                u32x4 o; o.x = cvt_pk_bf16(st[0], st[1]); o.y = cvt_pk_bf16(st[2], st[3]); o.z = cvt_pk_bf16(st[4], st[5]); o.w = cvt_pk_bf16(st[6], st[7]); p[(size_t)n * 4096] = o;
                st[0] = st[0] * d0[0] + bflo(w.x); st[1] = st[1] * d0[1] + bfhi(w.x); st[2] = st[2] * d0[2] + bflo(w.y); st[3] = st[3] * d0[3] + bfhi(w.y);
                st[4] = st[4] * d1[0] + bflo(w.z); st[5] = st[5] * d1[1] + bfhi(w.z); st[6] = st[6] * d1[2] + bflo(w.w); st[7] = st[7] * d1[3] + bfhi(w.w); }
        }
        __syncthreads();
        { pg8::QkVoPtrs P{(const char*)kcvc, (const char*)W_cqb, (const char*)W_coT, 1024, 0, 0};
          pg8::QkVoPtrs Pq = P; Pq.lda = 2 * DM; Pq.ldb = DM; pg8::LinearOrder Sq{256, F.G, F.vcu, 0};
          pg8::EpiQkVo E{WqkT, WvoT};
          pg8::gemm_phase<pg8::EpiQkVo, pg8::LinearOrder, pg8::QkVoPtrs, true>(F.lds, Pq, Sq, E);
          pg8::QkVoPtrs Pv = P; Pv.lda = DM; Pv.ldb = 2 * DM;
          pg8::LinearOrder Sv{256, F.G, F.vcu, 256};
          pg8::gemm_phase<pg8::EpiQkVo, pg8::LinearOrder, pg8::QkVoPtrs, true>(F.lds, Pv, Sv, E); }
        {
            char* al = F.ldsg;
            const int total = 64 * 8;
            int L = F.vcu;
            if (L < total) {
                int pass = 0; mb::BlockRef cur = moba_ref(qkvh, omix, kmean, L, 0); mb::Seam S;
                mb::moba_prime(cur, al, S);
                for (;;) {
                    const bool more_pass = pass == 0, more_item = L + F.G < total, last = !more_pass && !more_item;
                    int passn = pass + 1, Ln = L; if (!more_pass) { passn = 0; Ln = more_item ? L + F.G : L; }
                    const mb::BlockRef nxt = last ? cur : moba_ref(qkvh, omix, kmean, Ln, passn);
                    mb::moba_block(cur, nxt, al, S);
                    if (last) break;
                    cur = nxt; pass = passn; L = Ln;
                }
            }
            VM_WAIT(); __syncthreads();
        }
    }
    SEAM(4);

    if (IN(5)) {
        for (int un = F.vcu; un < 2048; un += F.G) gla::gc_unit(F.lds, un, proj, dSt, gla_norm_g, omix, F.tid, F.wave, F.lane);
    }
    SEAM(5);

    if (IN(6)) {
        pg8::StdPtrs P{(const char*)omix, (const char*)W_outT, DM, DM, DM, 0, 0}; pg8::StaticOrder S; S.init(T, DM, F.G, (int)blockIdx.x);
        pg8::EpiResid<false> E{(const void*)hb, hb, part};
        pg8::gemm_phase<pg8::EpiResid<false>, pg8::StaticOrder, pg8::StdPtrs, true>(F.lds, P, S, E);
    }
    SEAM(6);
    if (IN(7)) {
        pg8::StdPtrs P{(const char*)hb, (const char*)WqkT, DM, DM, DM, 16, (size_t)1024 * DM * 2}; pg8::StaticOrder S; S.init(T, 1024, F.G, (int)blockIdx.x);
        pg8::EpiSoftmax E{Pm, part};
        pg8::gemm_phase<pg8::EpiSoftmax, pg8::StaticOrder, pg8::StdPtrs, false>(F.lds, P, S, E);
    }
    SEAM(7);
    if (IN(8)) {
        pg8::StdPtrs P{(const char*)Pm, (const char*)WvoT, 1024, 1024, 1024, 16, (size_t)DM * 1024 * 2}; pg8::StaticOrder S; S.init(T, DM, F.G, (int)blockIdx.x);
        pg8::EpiResid<false> E{(const void*)hb, hb, part};
        pg8::gemm_phase<pg8::EpiResid<false>, pg8::StaticOrder, pg8::StdPtrs, true>(F.lds, P, S, E);
    }
    SEAM(8);
    if (IN(9)) {
        for (int row = gw; row < T; row += 2 * NGW) { const int row2 = row + NGW;
            const float pa = part[(size_t)row * 64 + F.lane], pb = part[(size_t)row2 * 64 + F.lane];
            float st0, st1; quant_rows2(hb + (size_t)row * DM, hb + (size_t)row2 * DM, hq + (size_t)row * DM, hq + (size_t)row2 * DM, F.lane, st0, st1);
            const float rsa = 1.0f / sqrtf(wave_sum(pa) * (1.0f / DM) + EPS), rsb = 1.0f / sqrtf(wave_sum(pb) * (1.0f / DM) + EPS);
            if (F.lane == 0) { rowq2[row] = rsa * st0; rowq2[row2] = rsb * st1; }
        }
        { LAS float* red = (LAS float*)F.lds; const int half = F.wave >> 2, wv4 = F.wave & 3, tl = F.tid & 255;
          rot_rows<false, false>((const unsigned char*)W_dnT, (size_t)DFF * 2, r8s  , Wdq, (int)blockIdx.x * 16, 8, red, tl, half, wv4, F.lane, [&](int n, float st, float sm) { sw_dn[n] = st * (1.0f / 64.0f); cw_dn[n] = sm; }); }
    }
    SEAM(9);
    if (IN(10)) {
        pg8::StdPtrs P{(const char*)hq, (const char*)W_upq, DM / 2, DM / 2, DM / 2, 0, 0}; pg8::StaticOrder S; S.init(T, DFF, F.G, (int)blockIdx.x);
        pg8::EpiUpI8 E{(unsigned char*)Ub, r8s, rowq2, colq_up};
        pg8::gemm_phase<pg8::EpiUpI8, pg8::StaticOrder, pg8::StdPtrs, true, true>(F.lds, P, S, E);
    }
    SEAM(10);
    if (IN(11)) {
        LAS float* red = (LAS float*)F.lds; const int half = F.wave >> 2, wv4 = F.wave & 3, tl = F.tid & 255;
        rot_rows<true, true>((const unsigned char*)Ub, (size_t)R8_LD, r8s, uq, (int)blockIdx.x * 64, 32, red, tl, half, wv4, F.lane, [&](int row, float st, float sm) { sa_u[row] = st; m_u[row] = sm * (1.0f / DFF); });
    }
    SEAM(11);
    if (IN(12)) {
        pg8::StdPtrs P{(const char*)uq, (const char*)Wdq, DFF / 2, RQ_LD / 2, RQ_LD / 2, 0, 0}; pg8::StaticOrder S; S.init(T, DM, F.G, (int)blockIdx.x);
        pg8::EpiResidI8 E{hb, hb, part, sa_u, m_u, sw_dn, cw_dn};
        pg8::gemm_phase<pg8::EpiResidI8, pg8::StaticOrder, pg8::StdPtrs, true, true>(F.lds, P, S, E);
    }
    SEAM(12);
    if (IN(13)) {
        const f32x4* gfp = (const f32x4*)g_final + 2 * F.lane;
        for (int row = gw; row < T; row += 2 * NGW) {
            const int row2 = row + NGW;
            const float pa = part[(size_t)row * 64 + F.lane], pb = part[(size_t)row2 * 64 + F.lane];
            const u32x4* hp = (const u32x4*)(hb + (size_t)row * DM) + F.lane; const u32x4* hq = (const u32x4*)(hb + (size_t)row2 * DM) + F.lane; u32x4 wa[8], wb[8];
#pragma unroll
            for (int j = 0; j < 8; ++j) { wa[j] = hp[64 * j]; wb[j] = hq[64 * j]; }
            const float rsa = 1.0f / sqrtf(wave_sum(pa) * (1.0f / DM) + EPS), rsb = 1.0f / sqrtf(wave_sum(pb) * (1.0f / DM) + EPS);
            f32x4* oa = (f32x4*)(F.out + (size_t)row * DM) + 2 * F.lane; f32x4* ob = (f32x4*)(F.out + (size_t)row2 * DM) + 2 * F.lane;
#pragma unroll
            for (int j = 0; j < 8; ++j) { const f32x4 g0 = gfp[128 * j], g1 = gfp[128 * j + 1]; const u32x4 w = wa[j], w2 = wb[j];
                const f32x4 v0 = {bflo(w.x) * g0[0] * rsa, bfhi(w.x) * g0[1] * rsa, bflo(w.y) * g0[2] * rsa, bfhi(w.y) * g0[3] * rsa}, v1 = {bflo(w.z) * g1[0] * rsa, bfhi(w.z) * g1[1] * rsa, bflo(w.w) * g1[2] * rsa, bfhi(w.w) * g1[3] * rsa};
                const f32x4 u0 = {bflo(w2.x) * g0[0] * rsb, bfhi(w2.x) * g0[1] * rsb, bflo(w2.y) * g0[2] * rsb, bfhi(w2.y) * g0[3] * rsb}, u1 = {bflo(w2.z) * g1[0] * rsb, bfhi(w2.z) * g1[1] * rsb, bflo(w2.w) * g1[2] * rsb, bfhi(w2.w) * g1[3] * rsb};
                __builtin_nontemporal_store(v0, oa + 128 * j); __builtin_nontemporal_store(v1, oa + 128 * j + 1); __builtin_nontemporal_store(u0, ob + 128 * j); __builtin_nontemporal_store(u1, ob + 128 * j + 1); } }
    }
#undef IN
#undef SEAM
}

extern "C" void kernel_launch(void* const* d_in, const int* in_sizes, int n_in, void* d_out, int out_size, void* d_ws, size_t ws_size, hipStream_t stream) {
    static int grid = 0;
    if (grid == 0) {
        if (n_in != 18 || in_sizes[0] != T * DM || out_size != T * DM || ws_size < WS_END) { fprintf(stderr, "kernel_launch: unexpected shapes / workspace (n_in %d, ws %zu < %zu)\n", n_in, ws_size, (size_t)WS_END); grid = -1; return; }
        int dev = 0, cus = 0;
        if (hipGetDevice(&dev) != hipSuccess || hipDeviceGetAttribute(&cus, hipDeviceAttributeMultiprocessorCount, dev) != hipSuccess) { grid = -1; return; }
        if (hipFuncSetAttribute((const void*)fwd, hipFuncAttributeMaxDynamicSharedMemorySize, LDS_BYTES) != hipSuccess) { fprintf(stderr, "kernel_launch: hipFuncSetAttribute failed\n"); grid = -1; return; }
        int per_cu = 0; (void)hipOccupancyMaxActiveBlocksPerMultiprocessor(&per_cu, (const void*)fwd, NWAVES * 64, LDS_BYTES); (void)hipGetLastError();
        if (per_cu < 1) fprintf(stderr, "kernel_launch: occupancy query reports %d blocks per CU\n", per_cu);
        grid = cus;
        if (grid != 256) { fprintf(stderr, "kernel_launch: this kernel needs a 256-CU device (got %d)\n", grid); grid = -1; return; }
    }
    if (grid < 0) return;
    (void)hipMemsetAsync((char*)d_ws + WS_CTL, 0, CTL_ZERO_BYTES, stream);
    Args a{};
    for (int i = 0; i < 18; ++i) a.in[i] = (const float*)d_in[i];
    a.out = (float*)d_out; a.ws = (unsigned char*)d_ws;
#if MK_ONE_LAUNCH
    a.ph_lo = 0; a.ph_hi = NPHASE;
    hipLaunchKernelGGL(fwd, dim3(grid), dim3(NWAVES * 64), LDS_BYTES, stream, a);
#else
    for (int p = 0; p < NPHASE; ++p) { a.ph_lo = p; a.ph_hi = p + 1;
        for (int rep = 0; rep < 1 + ((PROBE_DUP >> p) & 1) * PROBE_DUP_N; ++rep) hipLaunchKernelGGL(fwd, dim3(grid), dim3(NWAVES * 64), LDS_BYTES, stream, a); }
#endif
}
```
